# Optimizing an MI355X kernel written in HIP

```python
import math
import jax, jax.numpy as jnp
from jax import lax
import numpy as np

D_MODEL = 1024
BATCH = 8
SEQ = 2048
DEPTH = 2

PLE_DIM = 256
BLOCK_Q = 128
DIFF_HEADS = 4
DIFF_DK = 64
DIFF_DV = 2 * DIFF_DK
RET_HEADS = 4
RET_DK = 64
RET_DV = 128
RET_CHUNK = 128
FOX_HEADS = 16
FOX_DH = D_MODEL // FOX_HEADS
REL_BUCKETS = 32
REL_MAX_DIST = 128
N_GROUPS = 4
EXPERTS_PER_GROUP = 4
N_EXPERTS = N_GROUPS * EXPERTS_PER_GROUP
TOP_K = 2
D_FF_EXPERT = D_MODEL // 2
DEEPNORM_ALPHA = (2 * DEPTH) ** 0.25
DEEPNORM_BETA = (8 * DEPTH) ** -0.25
LN_EPS = 1e-5
ROPE_BASE = 10000.0

A_QK = DIFF_HEADS * 2 * DIFF_DK
A_V = DIFF_HEADS * DIFF_DV
B_QK = RET_HEADS * RET_DK
B_V = RET_HEADS * RET_DV
EVEN_IN = 2 * A_QK + A_V + 2 * B_QK + 2 * B_V
EVEN_OUT = A_V + B_V
ODD_IN = 3 * FOX_HEADS * FOX_DH + FOX_HEADS

kernel_name = "hybrid_diffattn_retnet_fox_groupmoe"


def layer_norm(x, g, b):
    xf = x.astype(jnp.float32)
    mu = jnp.mean(xf, -1, keepdims=True)
    var = jnp.mean(jnp.square(xf - mu), -1, keepdims=True)
    return ((xf - mu) * lax.rsqrt(var + LN_EPS) * g.astype(jnp.float32) + b.astype(jnp.float32)).astype(x.dtype)


def head_rms_norm(y, g):
    yf = y.astype(jnp.float32)
    yf = yf * lax.rsqrt(jnp.mean(jnp.square(yf), -1, keepdims=True) + LN_EPS)
    return (yf * g.astype(jnp.float32)).astype(y.dtype)


def head_layer_norm(y, g):
    yf = y.astype(jnp.float32)
    mu = jnp.mean(yf, -1, keepdims=True)
    var = jnp.mean(jnp.square(yf - mu), -1, keepdims=True)
    return ((yf - mu) * lax.rsqrt(var + LN_EPS) * g.astype(jnp.float32)).astype(y.dtype)


def to_heads(t, n_heads):
    b, s, _ = t.shape
    return t.reshape(b, s, n_heads, -1).transpose(0, 2, 1, 3)


def merge_heads(t):
    b, h, s, d = t.shape
    return t.transpose(0, 2, 1, 3).reshape(b, s, h * d)


def rotary(x, pos):
    half = x.shape[-1] // 2
    inv = ROPE_BASE ** (-jnp.arange(half, dtype=jnp.float32) / half)
    ang = pos.astype(jnp.float32)[:, None] * inv[None, :]
    cos, sin = jnp.cos(ang), jnp.sin(ang)
    x1, x2 = x[..., :half], x[..., half:]
    return jnp.concatenate([x1 * cos - x2 * sin, x2 * cos + x1 * sin], -1).astype(x.dtype)


def t5_bucket(dist):
    max_exact = REL_BUCKETS // 2
    d = jnp.maximum(dist, 1).astype(jnp.float32)
    large = max_exact + (jnp.log(d / max_exact) / math.log(REL_MAX_DIST / max_exact)
                         * (REL_BUCKETS - max_exact)).astype(jnp.int32)
    large = jnp.minimum(large, REL_BUCKETS - 1)
    return jnp.where(dist < max_exact, dist, large)


def sweep_query_blocks(fn, seq):
    out = lax.map(fn, jnp.arange(seq // BLOCK_Q) * BLOCK_Q)
    n, b, h, q, d = out.shape
    return out.transpose(1, 2, 0, 3, 4).reshape(b, h, n * q, d)


def diff_attention(q1, q2, k1, k2, v, rel_bias, lam):
    seq = q1.shape[2]
    key_pos = jnp.arange(seq)
    scale = DIFF_DK ** -0.5

    def block(start):
        q_pos = start + jnp.arange(BLOCK_Q)
        dist = q_pos[:, None] - key_pos[None, :]
        causal = dist >= 0
        bias = jnp.moveaxis(rel_bias[t5_bucket(jnp.maximum(dist, 0))], -1, 0).astype(jnp.float32)

        def probs(q, k):
            qb = lax.dynamic_slice_in_dim(q, start, BLOCK_Q, axis=2)
            s = jnp.einsum('bhqd,bhkd->bhqk', qb, k).astype(jnp.float32) * scale + bias
            return jax.nn.softmax(jnp.where(causal, s, -jnp.inf), axis=-1)

        a = probs(q1, k1) - lam * probs(q2, k2)
        return jnp.einsum('bhqk,bhkd->bhqd', a.astype(v.dtype), v)

    return sweep_query_blocks(block, seq)


def retention(q, k, v):
    b, h, s, dk = q.shape
    dv = v.shape[-1]
    c = RET_CHUNK
    n = s // c
    log_g = jnp.log1p(-jnp.exp2(-5.0 - jnp.arange(h, dtype=jnp.float32)))
    j = jnp.arange(c, dtype=jnp.float32)
    rel = j[:, None] - j[None, :]
    decay_in = jnp.where(rel >= 0, jnp.exp(jnp.maximum(rel, 0.0)[None] * log_g[:, None, None]), 0.0)
    q_decay = jnp.exp((j + 1.0)[None] * log_g[:, None])
    k_decay = jnp.exp((c - 1.0 - j)[None] * log_g[:, None])
    chunk_decay = jnp.exp(c * log_g)

    qc = q.reshape(b, h, n, c, dk)
    kc = k.reshape(b, h, n, c, dk)
    vc = v.reshape(b, h, n, c, dv)
    scores = jnp.einsum('bhncd,bhnmd->bhncm', qc, kc) * decay_in[None, :, None]
    inner = jnp.einsum('bhncm,bhnme->bhnce', scores, vc)
    kv = jnp.einsum('bhnmd,bhnme->bhnde', kc * k_decay[None, :, None, :, None], vc)

    def step(state, kv_i):
        return chunk_decay[None, :, None, None] * state + kv_i, state

    init = jnp.zeros((b, h, dk, dv), kv.dtype)
    _, state_prev = lax.scan(step, init, jnp.moveaxis(kv, 2, 0))
    state_prev = jnp.moveaxis(state_prev, 0, 2)
    cross = jnp.einsum('bhncd,bhnde->bhnce', qc * q_decay[None, :, None, :, None], state_prev)
    return (inner + cross).reshape(b, h, s, dv).astype(v.dtype)


def forgetting_attention(q, k, v, log_f):
    seq = q.shape[2]
    key_pos = jnp.arange(seq)
    scale = FOX_DH ** -0.5
    cum = jnp.cumsum(log_f.astype(jnp.float32), axis=-1)

    def block(start):
        q_pos = start + jnp.arange(BLOCK_Q)
        causal = q_pos[:, None] >= key_pos[None, :]
        qb = lax.dynamic_slice_in_dim(q, start, BLOCK_Q, axis=2)
        cq = lax.dynamic_slice_in_dim(cum, start, BLOCK_Q, axis=2)
        s = (jnp.einsum('bhqd,bhkd->bhqk', qb, k).astype(jnp.float32) * scale
             + cq[..., :, None] - cum[..., None, :])
        pr = jax.nn.softmax(jnp.where(causal, s, -jnp.inf), axis=-1)
        return jnp.einsum('bhqk,bhkd->bhqd', pr.astype(v.dtype), v)

    return sweep_query_blocks(block, seq)


def even_mixer(x, w_in, w_out, lam_params, diff_g, ret_g, rel_bias, layer_idx):
    b, s, _ = x.shape
    u = x @ w_in
    cuts = np.cumsum([A_QK, A_QK, A_V, B_QK, B_QK, B_V])
    qa, ka, va, qb, kb, vb, gb = jnp.split(u, cuts, axis=-1)
    qa = qa.reshape(b, s, DIFF_HEADS, 2, DIFF_DK).transpose(0, 2, 3, 1, 4)
    ka = ka.reshape(b, s, DIFF_HEADS, 2, DIFF_DK).transpose(0, 2, 3, 1, 4)
    va = to_heads(va, DIFF_HEADS)
    lam_init = 0.8 - 0.6 * math.exp(-0.3 * layer_idx)
    lp = lam_params.astype(jnp.float32)
    lam = jnp.exp(jnp.sum(lp[0] * lp[1])) - jnp.exp(jnp.sum(lp[2] * lp[3])) + lam_init
    ya = diff_attention(qa[:, :, 0], qa[:, :, 1], ka[:, :, 0], ka[:, :, 1], va, rel_bias, lam)
    ya = head_rms_norm(ya, diff_g) * (1.0 - lam_init)
    pos = jnp.arange(s)
    qr = rotary(to_heads(qb, RET_HEADS), pos)
    kr = rotary(to_heads(kb, RET_HEADS), pos) * (RET_DK ** -0.5)
    yb = head_layer_norm(retention(qr, kr, to_heads(vb, RET_HEADS)), ret_g)
    yb = jax.nn.silu(gb) * merge_heads(yb)
    y = jnp.concatenate([merge_heads(ya).astype(x.dtype), yb.astype(x.dtype)], axis=-1)
    return y @ w_out


def odd_mixer(x, w_in, b_forget, w_out):
    u = x @ w_in
    width = FOX_HEADS * FOX_DH
    q, k, v, f_logit = jnp.split(u, [width, 2 * width, 3 * width], axis=-1)
    log_f = jax.nn.log_sigmoid((f_logit + b_forget).astype(jnp.float32)).transpose(0, 2, 1)
    y = forgetting_attention(to_heads(q, FOX_HEADS), to_heads(k, FOX_HEADS), to_heads(v, FOX_HEADS), log_f)
    return merge_heads(y) @ w_out


def grouped_moe(h, router_w, w_gate, w_up, w_down):
    b, s, _ = h.shape
    probs = jax.nn.softmax(jnp.einsum('bsd,de->bse', h, router_w).astype(jnp.float32), axis=-1)
    grp = probs.reshape(b, s, N_GROUPS, EXPERTS_PER_GROUP)
    grp_score = jnp.sum(lax.top_k(grp, TOP_K)[0], axis=-1)
    best = jnp.argmax(grp_score, axis=-1)
    in_group = jnp.repeat(jax.nn.one_hot(best, N_GROUPS, dtype=jnp.bool_), EXPERTS_PER_GROUP, axis=-1)
    vals, idx = lax.top_k(jnp.where(in_group, probs, -1.0), TOP_K)
    gates = vals / jnp.sum(vals, -1, keepdims=True)
    dense_gate = jnp.sum(jax.nn.one_hot(idx, N_EXPERTS, dtype=jnp.float32) * gates[..., None], axis=-2)
    dense_gate = dense_gate.astype(h.dtype)
    y = jnp.zeros_like(h)
    for e in range(N_EXPERTS):
        a = jax.nn.silu(h @ w_gate[e]) * (h @ w_up[e])
        y = y + dense_gate[..., e:e + 1] * (a @ w_down[e])
    return y


def setup_inputs(seed: int = 0) -> dict:
    key = jax.random.key(seed)
    ks = jax.random.split(key, 24)
    f32 = jnp.float32
    n_even = (DEPTH + 1) // 2
    n_odd = DEPTH // 2
    beta = DEEPNORM_BETA

    def nrm(k, shape, scale):
        return jax.random.normal(k, shape, f32) * scale

    even_cols = np.concatenate([np.ones(2 * A_QK), np.full(A_V, beta), np.ones(2 * B_QK),
                                np.full(B_V, beta), np.ones(B_V)]).astype(np.float32)
    odd_cols = np.concatenate([np.ones(2 * FOX_HEADS * FOX_DH), np.full(FOX_HEADS * FOX_DH, beta),
                               np.full(FOX_HEADS, 0.5)]).astype(np.float32)
    return {
        "x": nrm(ks[0], (BATCH, SEQ, D_MODEL), 1.0),
        "p": nrm(ks[1], (DEPTH, BATCH, SEQ, PLE_DIM), 1.0),
        "rel_bias": nrm(ks[2], (REL_BUCKETS, DIFF_HEADS), 0.5),
        "router_w": nrm(ks[3], (D_MODEL, N_EXPERTS), D_MODEL ** -0.5),
        "even_w_in": nrm(ks[4], (n_even, D_MODEL, EVEN_IN), D_MODEL ** -0.5) * jnp.asarray(even_cols),
        "even_w_out": nrm(ks[5], (n_even, EVEN_OUT, D_MODEL), beta * EVEN_OUT ** -0.5),
        "even_lambda": nrm(ks[6], (n_even, 4, DIFF_DK), 0.1),
        "even_diff_norm": 1.0 + nrm(ks[7], (n_even, DIFF_DV), 0.02),
        "even_ret_norm": 1.0 + nrm(ks[8], (n_even, RET_DV), 0.02),
        "odd_w_in": nrm(ks[9], (n_odd, D_MODEL, ODD_IN), D_MODEL ** -0.5) * jnp.asarray(odd_cols),
        "odd_b_forget": jax.random.uniform(ks[10], (n_odd, FOX_HEADS), f32, 1.0, 4.0),
        "odd_w_out": nrm(ks[11], (n_odd, FOX_HEADS * FOX_DH, D_MODEL), beta * D_MODEL ** -0.5),
        "ln_mix_g": 1.0 + nrm(ks[12], (DEPTH, D_MODEL), 0.02),
        "ln_mix_b": nrm(ks[13], (DEPTH, D_MODEL), 0.02),
        "ln_ffn_g": 1.0 + nrm(ks[14], (DEPTH, D_MODEL), 0.02),
        "ln_ffn_b": nrm(ks[15], (DEPTH, D_MODEL), 0.02),
        "moe_w_gate": nrm(ks[16], (DEPTH, N_EXPERTS, D_MODEL, D_FF_EXPERT), beta * D_MODEL ** -0.5),
        "moe_w_up": nrm(ks[17], (DEPTH, N_EXPERTS, D_MODEL, D_FF_EXPERT), beta * D_MODEL ** -0.5),
        "moe_w_down": nrm(ks[18], (DEPTH, N_EXPERTS, D_FF_EXPERT, D_MODEL), beta * D_FF_EXPERT ** -0.5),
        "ple_proj": nrm(ks[19], (DEPTH, PLE_DIM, D_MODEL), 0.5 * PLE_DIM ** -0.5),
        "ple_gate": nrm(ks[20], (DEPTH, D_MODEL, D_MODEL), D_MODEL ** -0.5),
    }


def reference(x, p, rel_bias, router_w, even_w_in, even_w_out, even_lambda, even_diff_norm,
              even_ret_norm, odd_w_in, odd_b_forget, odd_w_out, ln_mix_g, ln_mix_b,
              ln_ffn_g, ln_ffn_b, moe_w_gate, moe_w_up, moe_w_down, ple_proj, ple_gate):
    for i in range(DEPTH):
        j = i // 2
        if i % 2 == 0:
            mix = even_mixer(x, even_w_in[j], even_w_out[j], even_lambda[j], even_diff_norm[j],
                             even_ret_norm[j], rel_bias, i)
        else:
            mix = odd_mixer(x, odd_w_in[j], odd_b_forget[j], odd_w_out[j])
        h = layer_norm(DEEPNORM_ALPHA * x + mix.astype(x.dtype), ln_mix_g[i], ln_mix_b[i])
        ffn = grouped_moe(h, router_w, moe_w_gate[i], moe_w_up[i], moe_w_down[i])
        h = layer_norm(DEEPNORM_ALPHA * h + ffn, ln_ffn_g[i], ln_ffn_b[i])
        x = h + jax.nn.sigmoid(h @ ple_gate[i]) * (p[i] @ ple_proj[i])
    return x
```

```cpp
#include <hip/hip_runtime.h>
#include <cstdio>
#include <cstdint>
#include <cmath>

namespace nv {
constexpr int BATCH = 8, SEQ = 2048, DM = 1024, T = BATCH * SEQ;
constexpr int EVEN_IN = 3072, ODD_IN = 3088;
constexpr float LN_EPS = 1e-5f;
constexpr float ALPHA = 1.41421356237309515f;

__device__ __forceinline__ float wave_sum(float v) {
#pragma unroll
    for (int o = 1; o < 64; o <<= 1) v += __shfl_xor(v, o);
    return v;
}
__device__ __forceinline__ float wave_max(float v) {
#pragma unroll
    for (int o = 1; o < 64; o <<= 1) v = fmaxf(v, __shfl_xor(v, o));
    return v;
}

__global__ __launch_bounds__(256) void gemm_f32(const float* __restrict__ A, int lda, const float* __restrict__ B, int ldb,
                                                 float* __restrict__ C, int ldc, int M, int N, int K) {
    __shared__ float As[16][68];
    __shared__ float Bs[16][68];
    const int tid = threadIdx.x, tx = tid & 15, ty = tid >> 4;
    const int m0 = blockIdx.y * 64, n0 = blockIdx.x * 64;
    float acc[4][4];
#pragma unroll
    for (int i = 0; i < 4; ++i)
#pragma unroll
        for (int j = 0; j < 4; ++j) acc[i][j] = 0.f;
    for (int k0 = 0; k0 < K; k0 += 16) {
        {
            const int r = tid >> 2, c = (tid & 3) * 4;
            const float4 v = *(const float4*)(A + (size_t)(m0 + r) * lda + k0 + c);
            As[c][r] = v.x; As[c + 1][r] = v.y; As[c + 2][r] = v.z; As[c + 3][r] = v.w;
        }
        {
            const int r = tid >> 4, c = (tid & 15) * 4, n = n0 + c;
            float4 v = make_float4(0.f, 0.f, 0.f, 0.f);
            if (n < N) v = *(const float4*)(B + (size_t)(k0 + r) * ldb + n);
            Bs[r][c] = v.x; Bs[r][c + 1] = v.y; Bs[r][c + 2] = v.z; Bs[r][c + 3] = v.w;
        }
        __syncthreads();
#pragma unroll
        for (int kk = 0; kk < 16; ++kk) {
            float a[4], b[4];
#pragma unroll
            for (int i = 0; i < 4; ++i) a[i] = As[kk][ty * 4 + i];
#pragma unroll
            for (int j = 0; j < 4; ++j) b[j] = Bs[kk][tx * 4 + j];
#pragma unroll
            for (int i = 0; i < 4; ++i)
#pragma unroll
                for (int j = 0; j < 4; ++j) acc[i][j] += a[i] * b[j];
        }
        __syncthreads();
    }
#pragma unroll
    for (int i = 0; i < 4; ++i) {
        const int m = m0 + ty * 4 + i, n = n0 + tx * 4;
        if (n < N) *(float4*)(C + (size_t)m * ldc + n) = make_float4(acc[i][0], acc[i][1], acc[i][2], acc[i][3]);
    }
}

__global__ void tables_kernel(float2* rope, float* bt, float* lamp, const float* rel_bias, const float* lam_params) {
    const int gid = blockIdx.x * blockDim.x + threadIdx.x;
    if (gid < SEQ * 32) {
        const int s = gid / 32, i = gid % 32;
        const double inv = pow(10000.0, -(double)i / 32.0);
        const double ang = (double)s * inv;
        rope[gid] = make_float2((float)cos(ang), (float)sin(ang));
    }
    if (gid < 4 * 128) {
        const int h = gid / 128, dist = gid % 128;
        int bucket;
        if (dist < 16) bucket = dist;
        else {
            const float d = (float)dist;
            int large = 16 + (int)(logf(d / 16.0f) / logf(8.0f) * 16.0f);
            bucket = large < 31 ? large : 31;
        }
        bt[gid] = rel_bias[bucket * 4 + h];
    }
    if (gid == 0) {
        float s01 = 0.f, s23 = 0.f;
        for (int i = 0; i < 64; ++i) { s01 += lam_params[i] * lam_params[64 + i]; s23 += lam_params[128 + i] * lam_params[192 + i]; }
        lamp[0] = expf(s01) - expf(s23) + 0.2f;
    }
}

__global__ void rope_apply(float* U, const float2* rope) {
    const int gid = blockIdx.x * blockDim.x + threadIdx.x;
    if (gid >= T * 4 * 32) return;
    const int i = gid & 31, h = (gid >> 5) & 3, t = gid >> 7, s = t % SEQ;
    const float2 cs = rope[s * 32 + i];
    float* q = U + (size_t)t * EVEN_IN + 1536 + h * 64;
    float* k = U + (size_t)t * EVEN_IN + 1792 + h * 64;
    const float q1 = q[i], q2 = q[i + 32];
    q[i] = q1 * cs.x - q2 * cs.y; q[i + 32] = q2 * cs.x + q1 * cs.y;
    const float k1 = k[i], k2 = k[i + 32];
    k[i] = (k1 * cs.x - k2 * cs.y) * 0.125f; k[i + 32] = (k2 * cs.x + k1 * cs.y) * 0.125f;
}

__device__ __forceinline__ float dot64(const float* __restrict__ qs  , const float* __restrict__ kp) {
    float acc = 0.f;
#pragma unroll
    for (int d = 0; d < 64; d += 4) { const float4 kv = *(const float4*)(kp + d); acc += qs[d] * kv.x + qs[d + 1] * kv.y + qs[d + 2] * kv.z + qs[d + 3] * kv.w; }
    return acc;
}

__global__ __launch_bounds__(64) void diff_attn_naive(const float* __restrict__ U, float* __restrict__ Y, const float* __restrict__ bt,
                                                       const float* __restrict__ lamp, const float* __restrict__ diff_g) {
    __shared__ float sc1[SEQ];
    __shared__ float sc2[SEQ];
    __shared__ float qs[128];
    const int lane = threadIdx.x;
    const int idx = blockIdx.x, q = idx % SEQ, h = (idx / SEQ) % 4, b = idx / (SEQ * 4);
    const float* Ub = U + (size_t)b * SEQ * EVEN_IN;
    qs[lane] = Ub[(size_t)q * EVEN_IN + h * 128 + lane];
    qs[lane + 64] = Ub[(size_t)q * EVEN_IN + h * 128 + 64 + lane];
    __syncthreads();
    const float lam = lamp[0];
    float m1 = -INFINITY, m2 = -INFINITY;
    for (int k = lane; k <= q; k += 64) {
        const float* kp = Ub + (size_t)k * EVEN_IN + 512 + h * 128;
        int dist = q - k; if (dist > 127) dist = 127;
        const float bias = bt[h * 128 + dist];
        const float s1 = dot64(qs, kp) * 0.125f + bias, s2 = dot64(qs + 64, kp + 64) * 0.125f + bias;
        sc1[k] = s1; sc2[k] = s2; m1 = fmaxf(m1, s1); m2 = fmaxf(m2, s2);
    }
    m1 = wave_max(m1); m2 = wave_max(m2);
    float l1 = 0.f, l2 = 0.f;
    for (int k = lane; k <= q; k += 64) { const float e1 = expf(sc1[k] - m1), e2 = expf(sc2[k] - m2); sc1[k] = e1; sc2[k] = e2; l1 += e1; l2 += e2; }
    l1 = wave_sum(l1); l2 = wave_sum(l2);
    const float r1 = 1.f / l1, r2 = lam / l2;
    for (int k = lane; k <= q; k += 64) sc1[k] = sc1[k] * r1 - sc2[k] * r2;
    __syncthreads();
    float a0 = 0.f, a1 = 0.f;
    const float* vp = Ub + 1024 + h * 128 + lane;
    for (int k = 0; k <= q; ++k) { const float a = sc1[k]; a0 += a * vp[(size_t)k * EVEN_IN]; a1 += a * vp[(size_t)k * EVEN_IN + 64]; }
    const float ss = wave_sum(a0 * a0 + a1 * a1);
    const float r = rsqrtf(ss * (1.f / 128.f) + LN_EPS) * 0.8f;
    float* yp = Y + (size_t)(b * SEQ + q) * DM + h * 128;
    yp[lane] = a0 * r * diff_g[lane]; yp[lane + 64] = a1 * r * diff_g[lane + 64];
}

__global__ __launch_bounds__(64) void retention_naive(const float* __restrict__ U, float* __restrict__ Y, const float* __restrict__ ret_g) {
    __shared__ float sc[SEQ];
    __shared__ float qs[64];
    const int lane = threadIdx.x;
    const int idx = blockIdx.x, t = idx % SEQ, h = (idx / SEQ) % 4, b = idx / (SEQ * 4);
    const float* Ub = U + (size_t)b * SEQ * EVEN_IN;
    qs[lane] = Ub[(size_t)t * EVEN_IN + 1536 + h * 64 + lane];
    __syncthreads();
    const float log_g = log1pf(-exp2f(-5.0f - (float)h));
    for (int k = lane; k <= t; k += 64) {
        const float* kp = Ub + (size_t)k * EVEN_IN + 1792 + h * 64;
        sc[k] = dot64(qs, kp) * expf((float)(t - k) * log_g);
    }
    __syncthreads();
    float a0 = 0.f, a1 = 0.f;
    const float* vp = Ub + 2048 + h * 128 + lane;
    for (int k = 0; k <= t; ++k) { const float a = sc[k]; a0 += a * vp[(size_t)k * EVEN_IN]; a1 += a * vp[(size_t)k * EVEN_IN + 64]; }
    const float mu = wave_sum(a0 + a1) * (1.f / 128.f);
    const float d0 = a0 - mu, d1 = a1 - mu;
    const float var = wave_sum(d0 * d0 + d1 * d1) * (1.f / 128.f);
    const float r = rsqrtf(var + LN_EPS);
    const float* gp = Ub + (size_t)t * EVEN_IN + 2560 + h * 128;
    const float g0 = gp[lane], g1 = gp[lane + 64];
    float* yp = Y + (size_t)(b * SEQ + t) * DM + 512 + h * 128;
    yp[lane] = (g0 / (1.f + expf(-g0))) * (d0 * r * ret_g[lane]);
    yp[lane + 64] = (g1 / (1.f + expf(-g1))) * (d1 * r * ret_g[lane + 64]);
}

__global__ __launch_bounds__(256) void ln_kernel(const float* __restrict__ a, const float* __restrict__ bsrc, const float* __restrict__ g,
                                                  const float* __restrict__ beta, float* __restrict__ out) {
    const int lane = threadIdx.x & 63, row = blockIdx.x * 4 + (threadIdx.x >> 6);
    float v[16]; float s = 0.f;
#pragma unroll
    for (int j = 0; j < 16; ++j) { const int c = lane + 64 * j; v[j] = ALPHA * a[(size_t)row * DM + c] + bsrc[(size_t)row * DM + c]; s += v[j]; }
    const float mu = wave_sum(s) * (1.f / DM);
    float q = 0.f;
#pragma unroll
    for (int j = 0; j < 16; ++j) { v[j] -= mu; q += v[j] * v[j]; }
    const float r = rsqrtf(wave_sum(q) * (1.f / DM) + LN_EPS);
#pragma unroll
    for (int j = 0; j < 16; ++j) { const int c = lane + 64 * j; out[(size_t)row * DM + c] = v[j] * r * g[c] + beta[c]; }
}

__global__ __launch_bounds__(256) void moe_naive(const float* __restrict__ H, const float* __restrict__ router_w, const float* __restrict__ Wg,
                                                  const float* __restrict__ Wu, const float* __restrict__ Wd, float* __restrict__ F) {
    __shared__ float hs[DM];
    __shared__ float as[512];
    __shared__ float logit[16];
    __shared__ float p[16];
    __shared__ int sel_e[2];
    __shared__ float sel_g[2];
    const int tid = threadIdx.x, lane = tid & 63, w = tid >> 6, tok = blockIdx.x;
    for (int c = tid; c < DM; c += 256) hs[c] = H[(size_t)tok * DM + c];
    __syncthreads();
    for (int e = w * 4; e < w * 4 + 4; ++e) {
        float s = 0.f;
        for (int k = lane; k < DM; k += 64) s += hs[k] * router_w[k * 16 + e];
        s = wave_sum(s);
        if (lane == 0) logit[e] = s;
    }
    __syncthreads();
    if (tid == 0) {
        float mx = -INFINITY;
        for (int e = 0; e < 16; ++e) mx = fmaxf(mx, logit[e]);
        float sum = 0.f;
        for (int e = 0; e < 16; ++e) { p[e] = expf(logit[e] - mx); sum += p[e]; }
        for (int e = 0; e < 16; ++e) p[e] /= sum;
        int best = 0; float bs = -1.f; int bi0 = 0, bi1 = 1;
        for (int g = 0; g < 4; ++g) {
            int i0 = 0; for (int j = 1; j < 4; ++j) if (p[g * 4 + j] > p[g * 4 + i0]) i0 = j;
            int i1 = (i0 == 0) ? 1 : 0; for (int j = 0; j < 4; ++j) if (j != i0 && p[g * 4 + j] > p[g * 4 + i1]) i1 = j;
            const float sc = p[g * 4 + i0] + p[g * 4 + i1];
            if (sc > bs) { bs = sc; best = g; bi0 = i0; bi1 = i1; }
        }
        const float v0 = p[best * 4 + bi0], v1 = p[best * 4 + bi1];
        sel_e[0] = best * 4 + bi0; sel_e[1] = best * 4 + bi1; sel_g[0] = v0 / (v0 + v1); sel_g[1] = v1 / (v0 + v1);
    }
    __syncthreads();
    float y[4] = {0.f, 0.f, 0.f, 0.f};
    for (int kk = 0; kk < 2; ++kk) {
        const int e = sel_e[kk]; const float gt = sel_g[kk];
        const float* wg = Wg + (size_t)e * DM * 512; const float* wu = Wu + (size_t)e * DM * 512; const float* wd = Wd + (size_t)e * 512 * DM;
        float g0 = 0.f, g1 = 0.f, u0 = 0.f, u1 = 0.f;
        for (int k = 0; k < DM; ++k) {
            const float hv = hs[k];
            g0 += hv * wg[(size_t)k * 512 + tid]; g1 += hv * wg[(size_t)k * 512 + tid + 256];
            u0 += hv * wu[(size_t)k * 512 + tid]; u1 += hv * wu[(size_t)k * 512 + tid + 256];
        }
        __syncthreads();
        as[tid] = (g0 / (1.f + expf(-g0))) * u0; as[tid + 256] = (g1 / (1.f + expf(-g1))) * u1;
        __syncthreads();
        float o0 = 0.f, o1 = 0.f, o2 = 0.f, o3 = 0.f;
        for (int k = 0; k < 512; ++k) {
            const float av = as[k];
            o0 += av * wd[(size_t)k * DM + tid]; o1 += av * wd[(size_t)k * DM + tid + 256]; o2 += av * wd[(size_t)k * DM + tid + 512]; o3 += av * wd[(size_t)k * DM + tid + 768];
        }
        y[0] += gt * o0; y[1] += gt * o1; y[2] += gt * o2; y[3] += gt * o3;
    }
#pragma unroll
    for (int j = 0; j < 4; ++j) F[(size_t)tok * DM + tid + 256 * j] = y[j];
}

__global__ void ple_final(const float* __restrict__ Hh, const float* __restrict__ G, const float* __restrict__ PP, float* __restrict__ out, int n4) {
    const int gid = blockIdx.x * blockDim.x + threadIdx.x;
    if (gid >= n4) return;
    const float4 h = ((const float4*)Hh)[gid], g = ((const float4*)G)[gid], p = ((const float4*)PP)[gid];
    float4 o;
    o.x = h.x + p.x / (1.f + expf(-g.x)); o.y = h.y + p.y / (1.f + expf(-g.y)); o.z = h.z + p.z / (1.f + expf(-g.z)); o.w = h.w + p.w / (1.f + expf(-g.w));
    ((float4*)out)[gid] = o;
}

__global__ void fox_cum(const float* __restrict__ U, const float* __restrict__ bf, float* __restrict__ cum) {
    const int gid = blockIdx.x * blockDim.x + threadIdx.x;
    if (gid >= BATCH * 16) return;
    const int h = gid & 15, b = gid >> 4;
    float c = 0.f;
    for (int s = 0; s < SEQ; ++s) {
        const float z = U[(size_t)(b * SEQ + s) * ODD_IN + 3072 + h] + bf[h];
        const float ls = fminf(z, 0.f) - log1pf(expf(-fabsf(z)));
        c += ls; cum[(size_t)gid * SEQ + s] = c;
    }
}

__global__ __launch_bounds__(64) void fox_attn_naive(const float* __restrict__ U, const float* __restrict__ cum, float* __restrict__ Y) {
    __shared__ float sc[SEQ];
    __shared__ float qs[64];
    const int lane = threadIdx.x;
    const int idx = blockIdx.x, q = idx % SEQ, h = (idx / SEQ) % 16, b = idx / (SEQ * 16);
    const float* Ub = U + (size_t)b * SEQ * ODD_IN;
    const float* cb = cum + (size_t)(b * 16 + h) * SEQ;
    qs[lane] = Ub[(size_t)q * ODD_IN + h * 64 + lane];
    __syncthreads();
    const float cq = cb[q];
    float m = -INFINITY;
    for (int k = lane; k <= q; k += 64) {
        const float s = dot64(qs, Ub + (size_t)k * ODD_IN + 1024 + h * 64) * 0.125f + cq - cb[k];
        sc[k] = s; m = fmaxf(m, s);
    }
    m = wave_max(m);
    float l = 0.f;
    for (int k = lane; k <= q; k += 64) { const float e = expf(sc[k] - m); sc[k] = e; l += e; }
    l = wave_sum(l);
    __syncthreads();
    float a0 = 0.f;
    const float* vp = Ub + 2048 + h * 64 + lane;
    for (int k = 0; k <= q; ++k) a0 += sc[k] * vp[(size_t)k * ODD_IN];
    Y[(size_t)(b * SEQ + q) * DM + h * 64 + lane] = a0 / l;
}

inline void gemm(hipStream_t st, const float* A, int lda, const float* B, int ldb, float* C, int ldc, int M, int N, int K) {
    dim3 grid((N + 63) / 64, M / 64);
    hipLaunchKernelGGL(gemm_f32, grid, dim3(256), 0, st, A, lda, B, ldb, C, ldc, M, N, K);
}
}

extern "C" void kernel_launch(void* const* d_in, const int* in_sizes, int n_in, void* d_out, int out_size, void* d_ws, size_t ws_size, hipStream_t stream) {
    using namespace nv;
    const float* x = (const float*)d_in[0];
    const float* p = (const float*)d_in[1];
    const float* rel_bias = (const float*)d_in[2];
    const float* router_w = (const float*)d_in[3];
    const float* even_w_in = (const float*)d_in[4];
    const float* even_w_out = (const float*)d_in[5];
    const float* even_lambda = (const float*)d_in[6];
    const float* even_diff_norm = (const float*)d_in[7];
    const float* even_ret_norm = (const float*)d_in[8];
    const float* odd_w_in = (const float*)d_in[9];
    const float* odd_b_forget = (const float*)d_in[10];
    const float* odd_w_out = (const float*)d_in[11];
    const float* ln_mix_g = (const float*)d_in[12];
    const float* ln_mix_b = (const float*)d_in[13];
    const float* ln_ffn_g = (const float*)d_in[14];
    const float* ln_ffn_b = (const float*)d_in[15];
    const float* moe_w_gate = (const float*)d_in[16];
    const float* moe_w_up = (const float*)d_in[17];
    const float* moe_w_down = (const float*)d_in[18];
    const float* ple_proj = (const float*)d_in[19];
    const float* ple_gate = (const float*)d_in[20];
    float* out = (float*)d_out;

    const size_t TD = (size_t)T * DM;
    float* ws = (float*)d_ws;
    float* U = ws;
    float* Y = U + (size_t)T * ODD_IN;
    float* H = Y + TD;
    float* SM = H + TD;
    float2* rope = (float2*)SM;
    float* bt = SM + SEQ * 64;
    float* lamp = bt + 512;
    float* cum = lamp + 16;
    const size_t need = ((size_t)(cum + 128 * SEQ - ws)) * 4;
    if (ws_size < need) { fprintf(stderr, "kernel_launch: workspace too small: %zu < %zu\n", ws_size, need); return; }
    float* MIX = U; float* FFN = U + TD; float* PP = U + 2 * TD;

    hipLaunchKernelGGL(tables_kernel, dim3(SEQ * 32 / 256), dim3(256), 0, stream, rope, bt, lamp, rel_bias, even_lambda);

    for (int layer = 0; layer < 2; ++layer) {
        const float* xin = layer == 0 ? x : out;
        if (layer == 0) {
            gemm(stream, xin, DM, even_w_in, EVEN_IN, U, EVEN_IN, T, EVEN_IN, DM);
            hipLaunchKernelGGL(rope_apply, dim3(T * 4 * 32 / 256), dim3(256), 0, stream, U, rope);
            hipLaunchKernelGGL(diff_attn_naive, dim3(BATCH * 4 * SEQ), dim3(64), 0, stream, U, Y, bt, lamp, even_diff_norm);
            hipLaunchKernelGGL(retention_naive, dim3(BATCH * 4 * SEQ), dim3(64), 0, stream, U, Y, even_ret_norm);
            gemm(stream, Y, DM, even_w_out, DM, MIX, DM, T, DM, DM);
        } else {
            gemm(stream, xin, DM, odd_w_in, ODD_IN, U, ODD_IN, T, ODD_IN, DM);
            hipLaunchKernelGGL(fox_cum, dim3(1), dim3(128), 0, stream, U, odd_b_forget, cum);
            hipLaunchKernelGGL(fox_attn_naive, dim3(BATCH * 16 * SEQ), dim3(64), 0, stream, U, cum, Y);
            gemm(stream, Y, DM, odd_w_out, DM, MIX, DM, T, DM, DM);
        }
        hipLaunchKernelGGL(ln_kernel, dim3(T / 4), dim3(256), 0, stream, xin, MIX, ln_mix_g + layer * DM, ln_mix_b + layer * DM, H);
        hipLaunchKernelGGL(moe_naive, dim3(T), dim3(256), 0, stream, H, router_w, moe_w_gate + (size_t)layer * 16 * DM * 512,
                           moe_w_up + (size_t)layer * 16 * DM * 512, moe_w_down + (size_t)layer * 16 * 512 * DM, FFN);
        hipLaunchKernelGGL(ln_kernel, dim3(T / 4), dim3(256), 0, stream, H, FFN, ln_ffn_g + layer * DM, ln_ffn_b + layer * DM, Y);
        gemm(stream, Y, DM, ple_gate + (size_t)layer * DM * DM, DM, FFN, DM, T, DM, DM);
        gemm(stream, p + (size_t)layer * T * 256, 256, ple_proj + (size_t)layer * 256 * DM, DM, PP, DM, T, DM, 256);
        hipLaunchKernelGGL(ple_final, dim3((int)(TD / 4 / 256)), dim3(256), 0, stream, Y, FFN, PP, out, (int)(TD / 4));
    }
}
```

```cpp
#include <hip/hip_runtime.h>
#include <cstdio>
#include <cstdint>
#include <cmath>

constexpr int BATCH = 8, SEQ = 2048, DM = 1024, T = BATCH * SEQ;
constexpr int EVEN_IN = 3072, ODD_IN = 3088, UBW = 3072;
constexpr float LN_EPS = 1e-5f;
constexpr float ALPHA = 1.41421356237309515f;
constexpr float LOG2E = 1.4426950408889634f;
constexpr float SCQ = 0.125f * LOG2E;

typedef unsigned short bf16_t;
#define GAS __attribute__((address_space(1)))
#define LAS __attribute__((address_space(3)))
typedef unsigned v4u __attribute__((ext_vector_type(4)));
typedef unsigned v2u __attribute__((ext_vector_type(2)));
typedef float f32x4 __attribute__((ext_vector_type(4)));
typedef float f32x16 __attribute__((ext_vector_type(16)));
typedef short bf16x8 __attribute__((ext_vector_type(8)));
typedef short s16x4 __attribute__((ext_vector_type(4)));

__device__ __forceinline__ unsigned f2bf(float f) { unsigned u = __builtin_bit_cast(unsigned, f); return (u + 0x7fffu + ((u >> 16) & 1u)) >> 16; }
__device__ __forceinline__ unsigned pk2(float lo, float hi) { return f2bf(lo) | (f2bf(hi) << 16); }
__device__ __forceinline__ float bf2f(bf16_t h) { return __builtin_bit_cast(float, (unsigned)h << 16); }
__device__ __forceinline__ float bflo(unsigned w) { return __builtin_bit_cast(float, w << 16); }
__device__ __forceinline__ float bfhi(unsigned w) { return __builtin_bit_cast(float, w & 0xffff0000u); }
__device__ __forceinline__ float ldv(const float* p) { return *p; }
__device__ __forceinline__ float ldv(const bf16_t* p) { return bf2f(*p); }
__device__ __forceinline__ void stv(float* p, float v) { *p = v; }
__device__ __forceinline__ void stv(bf16_t* p, float v) { *p = (bf16_t)f2bf(v); }
__device__ __forceinline__ float wave_sum(float v) {
#pragma unroll
    for (int o = 1; o < 64; o <<= 1) v += __shfl_xor(v, o);
    return v;
}
__device__ __forceinline__ float wave_max(float v) {
#pragma unroll
    for (int o = 1; o < 64; o <<= 1) v = fmaxf(v, __shfl_xor(v, o));
    return v;
}
__device__ __forceinline__ float silu_f(float g) { return g / (1.f + __expf(-g)); }
__device__ __forceinline__ float sigmoid_f(float g) { return 1.f / (1.f + __expf(-g)); }

constexpr size_t MiB = 1u << 20;
constexpr size_t WS_CTL = 0, CTL_ZERO_BYTES = 1 * MiB;
constexpr size_t WS_ROPE = 1 * MiB;
constexpr size_t WS_BT = 1 * MiB + 512 * 1024;
constexpr size_t WS_LAM = WS_BT + 4096;
constexpr size_t WS_CUM = 2 * MiB;
constexpr size_t WS_LF = 3 * MiB;
constexpr size_t WS_TOK = 4 * MiB;
constexpr size_t WS_LIST = 5 * MiB;
constexpr size_t WS_LISTG = 6 * MiB;
constexpr size_t WS_W = 9 * MiB;
constexpr size_t W_IN0 = WS_W, W_OUT0 = W_IN0 + 6 * MiB, W_IN1 = W_OUT0 + 2 * MiB, W_OUT1 = W_IN1 + 6 * MiB + 512 * 1024;
constexpr size_t W_PLEG = W_OUT1 + 2 * MiB, W_PLEP = W_PLEG + 4 * MiB, W_GU = W_PLEP + 1 * MiB, W_DN = W_GU + 64 * MiB, W_END = W_DN + 32 * MiB;
static_assert(W_END == 126 * MiB + 512 * 1024, "weights map");
constexpr size_t WS_A = 127 * MiB;
constexpr size_t WS_YS = WS_A, WS_ACT = WS_A + 64 * MiB;
constexpr size_t WS_B = 224 * MiB;
constexpr size_t WS_D = 256 * MiB;
constexpr size_t WS_PP = 288 * MiB;
constexpr size_t WS_END = 320 * MiB;
constexpr int CW_TMO = 0, CW_CODE = 1;
constexpr int CW_CNT = 64;
constexpr int CW_BAR = 4096;
#define MEGA_MASK 0x7E7F3
namespace pg8 {
constexpr int BM = 256, BK = 64, HALF = 128, HTB = HALF * BK * 2  , STAGE_BYTES = 8 * HTB, NXCD = 8, WGM = 8;

__host__ __device__ __forceinline__ int lds_byte(int r, int c) { const int st = (r >> 4) * 2 + (c >> 5), rr = r & 15, cc = c & 31, ob = rr * 64 + cc * 2; return st * 1024 + (ob ^ (((ob >> 9) & 1) << 5)); }
__host__ __device__ __forceinline__ void stage_rc(int b, int& R, int& C) { const int st = b / 1024, sb = b % 1024, swz = sb ^ (((sb >> 9) & 1) << 5); R = (st >> 1) * 16 + swz / 64; C = (st & 1) * 32 + (swz % 64) / 2; }
__host__ __device__ __forceinline__ int perm32(int rho) { const int n = rho >> 4, i = rho & 15; return 8 * (i >> 2) + 4 * n + (i & 3); }

struct Unit { const char* A; const char* B; int pm, pn, rows, aux; };


template <class Epi, class Sched, bool ALIGN_EPI, bool GATHER>
__device__ __forceinline__ void gemm_phase(LAS unsigned char* lds, const int K, const Sched& S, const Epi& E) {
    int tid_ = threadIdx.x; asm volatile("" : "+v"(tid_));
    const int tid = tid_, wid = __builtin_amdgcn_readfirstlane(tid >> 6), lane = tid & 63, wr = wid >> 2, wc = wid & 3, fr = lane & 15, fq = lane >> 4;
    const int nt = K / BK;
    unsigned voffA[2][2], voffB[2];
#pragma unroll
    for (int i = 0; i < 2; ++i) { int R, C; stage_rc(tid * 16 + i * 8192, R, C);
        voffA[0][i] = (unsigned)(R * K + C) * 2u; voffA[1][i] = voffA[0][i]; voffB[i] = (unsigned)(R * K + C) * 2u; }
    const size_t kstep = (size_t)(BK * 2);
    const size_t hstep = (size_t)HALF * K * 2;
    const size_t hA = GATHER ? (size_t)0 : hstep;
#define VA1 voffA[GATHER ? 1 : 0]
    const unsigned ldsw = (unsigned)wid * 1024u;
    const int aoff = lds_byte(wr * 64 + fr, fq * 8), boff = lds_byte(wc * 32 + fr, fq * 8);
#define PG8_SA(b, h) (((b) * 2 + (h)) * HTB)
#define PG8_SB(b, h) ((4 + (b) * 2 + (h)) * HTB)
#define PG8_STAGE(bufoff, gbase, voff) do { _Pragma("unroll") for (int _i = 0; _i < 2; ++_i) { unsigned _vo = (voff)[_i]; asm volatile("" : "+v"(_vo));     \
        __builtin_amdgcn_global_load_lds((const unsigned*)((const char*)(gbase) + _vo), (LAS unsigned*)(lds + (bufoff) + ldsw + _i * 8192), 16, 0, 0); } } while (0)
#define PG8_LDA(dst, b, h) do { _Pragma("unroll") for (int m = 0; m < 4; ++m) _Pragma("unroll") for (int k = 0; k < 2; ++k) dst[m][k] = *(const LAS bf16x8*)(lds + PG8_SA(b, h) + aoff + m * 2048 + k * 1024); } while (0)
#define PG8_LDB(dst, b, h) do { _Pragma("unroll") for (int n = 0; n < 2; ++n) _Pragma("unroll") for (int k = 0; k < 2; ++k) dst[n][k] = *(const LAS bf16x8*)(lds + PG8_SB(b, h) + boff + n * 2048 + k * 1024); } while (0)
#define PG8_MMA(ai, bj, At, Bt) do { __builtin_amdgcn_s_setprio(1); _Pragma("unroll") for (int m = 0; m < 4; ++m) _Pragma("unroll") for (int n = 0; n < 2; ++n) _Pragma("unroll") for (int k = 0; k < 2; ++k) \
        acc[ai][bj][m][n] = __builtin_amdgcn_mfma_f32_16x16x32_bf16(Bt[n][k], At[m][k], acc[ai][bj][m][n], 0, 0, 0); __builtin_amdgcn_s_setprio(0); } while (0)
#define PG8_WAIT_V(n) asm volatile("s_waitcnt vmcnt(" #n ")" ::: "memory")
#define PG8_WAIT_L(n) asm volatile("s_waitcnt lgkmcnt(" #n ")" ::: "memory")
#define PG8_BAR __builtin_amdgcn_s_barrier()
#define PG8_SCHED __builtin_amdgcn_sched_barrier(0)
    Unit cur, nxt; int ui = 0;
    if (!S.next(0, cur)) return;
    if constexpr (GATHER) S.voff(0, voffA);
    f32x4 acc[2][2][4][2];
#pragma unroll
    for (int a = 0; a < 2; ++a)
#pragma unroll
        for (int b = 0; b < 2; ++b)
#pragma unroll
            for (int m = 0; m < 4; ++m)
#pragma unroll
                for (int n = 0; n < 2; ++n) acc[a][b][m][n] = (f32x4){0.f, 0.f, 0.f, 0.f};
    bf16x8 At[4][2], B0[2][2], B1[2][2];
    const char* cA = cur.A; const char* cB = cur.B;
    PG8_STAGE(PG8_SB(0, 0), cB, voffB); PG8_STAGE(PG8_SB(0, 1), cB + hstep, voffB); PG8_STAGE(PG8_SA(0, 0), cA, voffA[0]); PG8_STAGE(PG8_SA(0, 1), cA + hA, VA1);
    if (wr == 1) PG8_BAR;
    PG8_WAIT_V(2); PG8_BAR;
    PG8_STAGE(PG8_SB(1, 0), cB + kstep, voffB); PG8_STAGE(PG8_SA(1, 0), cA + kstep, voffA[0]); PG8_STAGE(PG8_SB(1, 1), cB + hstep + kstep, voffB);
    PG8_WAIT_V(6); PG8_BAR;
    for (;;) {
        const bool has_next = S.next(ui + 1, nxt);
        const char* nA = has_next ? nxt.A : cA; const char* nB = has_next ? nxt.B : cB;
        for (int t = 0; t < nt; t += 2) {
            const bool last = (t == nt - 2);
            const char* a1 = cA + (size_t)(t + 1) * kstep;
            const char* a2 = last ? nA : cA + (size_t)(t + 2) * kstep; const char* b2 = last ? nB : cB + (size_t)(t + 2) * kstep;
            const char* a3 = a2 + kstep; const char* b3 = b2 + kstep;
            PG8_LDB(B0, 0, 0); PG8_LDB(B1, 0, 1); PG8_SCHED; PG8_LDA(At, 0, 0); PG8_STAGE(PG8_SA(1, 1), a1 + hA, VA1);
            if constexpr (GATHER) { if (last && has_next) S.voff(ui + 1, voffA); }
            PG8_WAIT_V(8); PG8_WAIT_L(0); PG8_BAR; PG8_MMA(0, 0, At, B0); PG8_MMA(0, 1, At, B1); PG8_BAR; PG8_SCHED;
            PG8_LDA(At, 0, 1); PG8_STAGE(PG8_SB(0, 0), b2, voffB); PG8_STAGE(PG8_SB(0, 1), b2 + hstep, voffB); PG8_STAGE(PG8_SA(0, 0), a2, voffA[0]);
            PG8_WAIT_V(8); PG8_WAIT_L(0); PG8_BAR; PG8_MMA(1, 0, At, B0); PG8_MMA(1, 1, At, B1); PG8_BAR; PG8_SCHED;
            PG8_LDB(B0, 1, 0); PG8_LDB(B1, 1, 1); PG8_SCHED; PG8_LDA(At, 1, 0); PG8_STAGE(PG8_SA(0, 1), a2 + hA, VA1);
            PG8_WAIT_V(8); PG8_WAIT_L(0); PG8_BAR; PG8_MMA(0, 0, At, B0); PG8_MMA(0, 1, At, B1); PG8_BAR; PG8_SCHED;
            PG8_LDA(At, 1, 1); PG8_STAGE(PG8_SB(1, 0), b3, voffB); PG8_STAGE(PG8_SB(1, 1), b3 + hstep, voffB); PG8_STAGE(PG8_SA(1, 0), a3, voffA[0]);
            PG8_WAIT_V(8); PG8_WAIT_L(0); PG8_BAR; PG8_MMA(1, 0, At, B0); PG8_MMA(1, 1, At, B1); PG8_BAR; PG8_SCHED;
        }
        if constexpr (ALIGN_EPI) { if (wr == 0) PG8_BAR; }
        E(acc, cur, wr, wc, fr, fq);
        if (!has_next) break;
#pragma unroll
        for (int a = 0; a < 2; ++a)
#pragma unroll
            for (int b = 0; b < 2; ++b)
#pragma unroll
                for (int m = 0; m < 4; ++m)
#pragma unroll
                    for (int n = 0; n < 2; ++n) acc[a][b][m][n] = (f32x4){0.f, 0.f, 0.f, 0.f};
        cur = nxt; cA = nA; cB = nB; ++ui;
        if constexpr (ALIGN_EPI) { if (wr == 1) PG8_BAR; }
    }
    PG8_WAIT_V(0);
    if constexpr (!ALIGN_EPI) { if (wr == 0) PG8_BAR; }
    PG8_BAR;
#undef VA1
#undef PG8_SA
#undef PG8_SB
#undef PG8_STAGE
#undef PG8_LDA
#undef PG8_LDB
#undef PG8_MMA
#undef PG8_WAIT_V
#undef PG8_WAIT_L
#undef PG8_BAR
#undef PG8_SCHED
}

struct DenseOrder {
    const char* A; const char* B; int nM, nN, nwg, G, c; size_t tstepA, tstepB;
    __device__ void init(const void* A_, const void* B_, int M, int N, int K, int G_, int c_) { A = (const char*)A_; B = (const char*)B_; nM = M / BM; nN = N / BM; nwg = nM * nN; G = G_; c = c_; tstepA = (size_t)BM * K * 2; tstepB = tstepA; }
    __device__ __forceinline__ bool next(int i, Unit& u) const {
        const long L = (long)i * G + c; if (L >= nwg) return false;
        int wgid = (int)L; { const int q = nwg / NXCD, r = nwg % NXCD, xcd = wgid % NXCD, off = wgid / NXCD; wgid = (xcd < r ? xcd * (q + 1) : r * (q + 1) + (xcd - r) * q) + off; }
        const int nig = WGM * nN, gid = wgid / nig, fm = gid * WGM, gsz = (nM - fm) < WGM ? (nM - fm) : WGM;
        u.pm = fm + ((wgid % nig) % gsz); u.pn = (wgid % nig) / gsz; u.A = A + (size_t)u.pm * tstepA; u.B = B + (size_t)u.pn * tstepB; u.rows = BM; u.aux = 0; return true;
    }
    __device__ __forceinline__ void voff(int, unsigned (&)[2][2]) const {}
};
}
namespace pg8 {
__device__ __forceinline__ v4u pack8(const f32x4 a, const f32x4 b) { v4u w; w.x = pk2(a[0], a[1]); w.y = pk2(a[2], a[3]); w.z = pk2(b[0], b[1]); w.w = pk2(b[2], b[3]); return w; }

struct EpiIn0 {
    bf16_t* UB; const float2* rope;
    __device__ __forceinline__ void operator()(const f32x4 (&acc)[2][2][4][2], const Unit& u, int wr, int wc, int fr, int fq) const {
        const int pn = u.pn;
        if (pn == 6 || pn == 7) {
            const float sc = (pn == 7) ? 0.125f : 1.f;
#pragma unroll
            for (int ai = 0; ai < 2; ++ai)
#pragma unroll
                for (int m = 0; m < 4; ++m) {
                    const int row = u.pm * BM + ai * HALF + wr * 64 + m * 16 + fr, s = row & (SEQ - 1);
                    const f32x4* rp = (const f32x4*)(rope + s * 32 + 8 * fq);
                    f32x4 o1[2], o2[2];
#pragma unroll
                    for (int n = 0; n < 2; ++n) {
                        const f32x4 cs0 = rp[2 * n], cs1 = rp[2 * n + 1];
                        const f32x4 x1 = acc[ai][0][m][n], x2 = acc[ai][1][m][n];
                        const f32x4 c = {cs0[0], cs0[2], cs1[0], cs1[2]}, sn = {cs0[1], cs0[3], cs1[1], cs1[3]};
                        o1[n] = (x1 * c - x2 * sn) * sc; o2[n] = (x2 * c + x1 * sn) * sc;
                    }
                    bf16_t* p = UB + (size_t)row * UBW + pn * BM + 64 * wc + 8 * fq;
                    *(v4u*)p = pack8(o1[0], o1[1]); *(v4u*)(p + 32) = pack8(o2[0], o2[1]);
                }
        } else {
            const float sc = (pn < 2) ? SCQ : 1.f;
#pragma unroll
            for (int ai = 0; ai < 2; ++ai)
#pragma unroll
                for (int m = 0; m < 4; ++m) {
                    const int row = u.pm * BM + ai * HALF + wr * 64 + m * 16 + fr;
                    bf16_t* p = UB + (size_t)row * UBW + pn * BM + 32 * wc + 8 * fq;
#pragma unroll
                    for (int bj = 0; bj < 2; ++bj) *(v4u*)(p + bj * HALF) = pack8(acc[ai][bj][m][0] * sc, acc[ai][bj][m][1] * sc);
                }
        }
    }
};

struct EpiIn1 {
    bf16_t* UB; float* LF;
    __device__ __forceinline__ void operator()(const f32x4 (&acc)[2][2][4][2], const Unit& u, int wr, int wc, int fr, int fq) const {
        const int pn = u.pn;
        if (pn == 12) {
            if (wc == 0 && fq < 2) {
#pragma unroll
                for (int ai = 0; ai < 2; ++ai)
#pragma unroll
                    for (int m = 0; m < 4; ++m) {
                        const int row = u.pm * BM + ai * HALF + wr * 64 + m * 16 + fr;
                        float* p = LF + (size_t)row * 16 + 8 * fq;
                        *(f32x4*)p = acc[ai][0][m][0]; *(f32x4*)(p + 4) = acc[ai][0][m][1];
                    }
            }
        } else {
            const float sc = (pn < 4) ? SCQ : 1.f;
#pragma unroll
            for (int ai = 0; ai < 2; ++ai)
#pragma unroll
                for (int m = 0; m < 4; ++m) {
                    const int row = u.pm * BM + ai * HALF + wr * 64 + m * 16 + fr;
                    bf16_t* p = UB + (size_t)row * UBW + pn * BM + 32 * wc + 8 * fq;
#pragma unroll
                    for (int bj = 0; bj < 2; ++bj) *(v4u*)(p + bj * HALF) = pack8(acc[ai][bj][m][0] * sc, acc[ai][bj][m][1] * sc);
                }
        }
    }
};

struct EpiF32 {
    float* O; int ldc;
    __device__ __forceinline__ void operator()(const f32x4 (&acc)[2][2][4][2], const Unit& u, int wr, int wc, int fr, int fq) const {
#pragma unroll
        for (int ai = 0; ai < 2; ++ai)
#pragma unroll
            for (int m = 0; m < 4; ++m) {
                const int row = u.pm * BM + ai * HALF + wr * 64 + m * 16 + fr;
                float* p = O + (size_t)row * ldc + u.pn * BM + 32 * wc + 8 * fq;
#pragma unroll
                for (int bj = 0; bj < 2; ++bj) { *(f32x4*)(p + bj * HALF) = acc[ai][bj][m][0]; *(f32x4*)(p + bj * HALF + 4) = acc[ai][bj][m][1]; }
            }
    }
};
struct EpiBf16 {
    bf16_t* O; int ldc;
    __device__ __forceinline__ void operator()(const f32x4 (&acc)[2][2][4][2], const Unit& u, int wr, int wc, int fr, int fq) const {
#pragma unroll
        for (int ai = 0; ai < 2; ++ai)
#pragma unroll
            for (int m = 0; m < 4; ++m) {
                const int row = u.pm * BM + ai * HALF + wr * 64 + m * 16 + fr;
                bf16_t* p = O + (size_t)row * ldc + u.pn * BM + 32 * wc + 8 * fq;
#pragma unroll
                for (int bj = 0; bj < 2; ++bj) *(v4u*)(p + bj * HALF) = pack8(acc[ai][bj][m][0], acc[ai][bj][m][1]);
            }
    }
};
struct EpiPle {
    float* H2; const bf16_t* PP; bf16_t* XB;
    __device__ __forceinline__ void operator()(const f32x4 (&acc)[2][2][4][2], const Unit& u, int wr, int wc, int fr, int fq) const {
#pragma unroll
        for (int ai = 0; ai < 2; ++ai)
#pragma unroll
            for (int m = 0; m < 4; ++m) {
                const int row = u.pm * BM + ai * HALF + wr * 64 + m * 16 + fr;
                const size_t off = (size_t)row * DM + u.pn * BM + 32 * wc + 8 * fq;
#pragma unroll
                for (int bj = 0; bj < 2; ++bj) {
                    float* hp = H2 + off + bj * HALF;
                    const f32x4 h0 = *(const f32x4*)hp, h1 = *(const f32x4*)(hp + 4);
                    const v4u pw = *(const v4u*)(PP + off + bj * HALF);
                    const f32x4 p0 = {bflo(pw.x), bfhi(pw.x), bflo(pw.y), bfhi(pw.y)}, p1 = {bflo(pw.z), bfhi(pw.z), bflo(pw.w), bfhi(pw.w)};
                    f32x4 o0, o1;
#pragma unroll
                    for (int j = 0; j < 4; ++j) { o0[j] = h0[j] + sigmoid_f(acc[ai][bj][m][0][j]) * p0[j]; o1[j] = h1[j] + sigmoid_f(acc[ai][bj][m][1][j]) * p1[j]; }
                    *(f32x4*)hp = o0; *(f32x4*)(hp + 4) = o1;
                    *(v4u*)(XB + off + bj * HALF) = pack8(o0, o1);
                }
            }
    }
};
}
#define RLX_AGENT __ATOMIC_RELAXED, __HIP_MEMORY_SCOPE_AGENT
#define XB_TMO      128
#define XB_XCNT(j)  (256  + 64 * (j))
#define XB_XSUB(j)  (1280 + 64 * (j))
#define XB_XGEN(j)  (2304 + 64 * (j))
#define XB_TOP      3328
#define XB_TOPGEN   3392
#define XCD_BAR_WORDS 3456
#define XB_SPIN_CAP (1u << 18)

__device__ __forceinline__ unsigned xb_ld(unsigned* p)              { return __hip_atomic_load(p, __ATOMIC_RELAXED, __HIP_MEMORY_SCOPE_AGENT); }
__device__ __forceinline__ unsigned xb_add(unsigned* p, unsigned v) { return __hip_atomic_fetch_add(p, v, __ATOMIC_RELAXED, __HIP_MEMORY_SCOPE_AGENT); }
__device__ __forceinline__ unsigned xb_xcc_id() { return (unsigned)__builtin_amdgcn_s_getreg((3 << 11) | 20) & 0xFu; }
#define XB_SPIN(cond, bar) do { unsigned _sp = 0; while (cond) { __builtin_amdgcn_s_sleep(1); \
    if ((++_sp & 255u) == 0u) { if (xb_ld(&(bar)[XB_TMO])) break; if (_sp > XB_SPIN_CAP) { atomicAdd(&(bar)[XB_TMO], 1u); break; } } } } while (0)

struct XcdBarrier {
    unsigned* bar; unsigned x;
    volatile LAS unsigned* st;
};

__device__ __forceinline__ XcdBarrier xcd_barrier_post(unsigned* bar, volatile LAS unsigned* st) {
    XcdBarrier b; b.bar = bar; b.x = xb_xcc_id(); b.st = st;
    if (threadIdx.x == 0) (void)xb_add(&bar[XB_XCNT(b.x)], 1u);
    return b;
}
__device__ __forceinline__ void xcd_barrier_complete(unsigned* bar, unsigned x, unsigned& nloc, unsigned& nx) {
    const unsigned G = gridDim.x * gridDim.y * gridDim.z;
    unsigned sum, cnt, mine, sp = 0u;
    for (;;) {
        sum = 0u; cnt = 0u; mine = 0u;
#pragma unroll
        for (unsigned j = 0; j < 16; ++j) { const unsigned c = xb_ld(&bar[XB_XCNT(j)]); sum += c; cnt += (c > 0u) ? 1u : 0u; mine = (j == x) ? c : mine; }
        if (sum == G) break;
        __builtin_amdgcn_s_sleep(1);
        if ((++sp & 255u) == 0u) { if (xb_ld(&bar[XB_TMO])) break; if (sp > XB_SPIN_CAP) { atomicAdd(&bar[XB_TMO], 1u); break; } }
    }
    nloc = mine > 0u ? mine : 1u; nx = cnt > 0u ? cnt : 1u;
}

__device__ __forceinline__ void xcd_barrier(const XcdBarrier& b) {
    asm volatile("s_waitcnt vmcnt(0)" ::: "memory");
    __syncthreads();
    if (threadIdx.x == 0) {
        unsigned* bar = b.bar;
        __builtin_amdgcn_s_waitcnt(0);
        unsigned nloc = b.st[0], nx = b.st[1];
        if (nloc == 0u) { xcd_barrier_complete(bar, b.x, nloc, nx); b.st[0] = nloc; b.st[1] = nx; }
        const unsigned old = xb_add(&bar[XB_XSUB(b.x)], 1u);
        const unsigned gen = old / nloc;
        if (old + 1u == (gen + 1u) * nloc) {
            __builtin_amdgcn_fence(__ATOMIC_RELEASE, "agent");
            asm volatile("s_waitcnt vmcnt(0)" ::: "memory");
            const unsigned og = xb_add(&bar[XB_TOP], 1u);
            const unsigned tg = og / nx;
            if (og + 1u == (tg + 1u) * nx) xb_add(&bar[XB_TOPGEN], 1u);
            else XB_SPIN(xb_ld(&bar[XB_TOPGEN]) == tg, bar);
            __builtin_amdgcn_fence(__ATOMIC_ACQUIRE, "agent");
            xb_add(&bar[XB_XGEN(b.x)], 1u);
            asm volatile("s_waitcnt vmcnt(0)" ::: "memory");
        } else {
            XB_SPIN(xb_ld(&bar[XB_XGEN(b.x)]) == gen, bar);
            __builtin_amdgcn_fence(__ATOMIC_ACQUIRE, "agent");
            asm volatile("s_waitcnt vmcnt(0)" ::: "memory");
        }
    }
    __syncthreads();
}

constexpr int NWAVES = 8;
constexpr int RING_OFF = 0, RING_BYTES = 131072;
constexpr int LDSCTL_OFF = RING_BYTES;
constexpr int MISC_OFF = LDSCTL_OFF + 320;
constexpr int MOE_TAB_OFF = LDSCTL_OFF + 1024;
constexpr int VOFF_OFF = MOE_TAB_OFF + 512;
constexpr int LDS_BYTES = 147456;
static_assert(VOFF_OFF + 3 * 4096 <= LDS_BYTES, "LDS map");

struct Args {
    const float* in[21]; float* out; unsigned char* ws; int ph_lo, ph_hi, li, pad;
};

struct Frame {
    LAS unsigned char* lds; volatile LAS unsigned* MISC; unsigned* ctl; unsigned char* ws;
    int tid, lane, wave, vcu, G;
};

__device__ __forceinline__ void p0_item(const float* __restrict__ src, int ld, int col0, int nvalid, int k0, bf16_t* __restrict__ dst, int Kd, LAS float* scr, int lane) {
    const int c = lane & 31;
#pragma unroll 8
    for (int i = 0; i < 32; ++i) { const int kk = 2 * i + (lane >> 5); scr[kk * 33 + c] = (c < nvalid) ? src[(size_t)(k0 + kk) * ld + col0 + c] : 0.f; }
    asm volatile("s_waitcnt lgkmcnt(0)" ::: "memory");
    const int ch = lane & 7;
#pragma unroll
    for (int j = 0; j < 4; ++j) { const int rho = (lane >> 3) + 8 * j; const LAS float* s = scr + (8 * ch) * 33 + pg8::perm32(rho);
        v4u o; o.x = pk2(s[0 * 33], s[1 * 33]); o.y = pk2(s[2 * 33], s[3 * 33]); o.z = pk2(s[4 * 33], s[5 * 33]); o.w = pk2(s[6 * 33], s[7 * 33]);
        *(v4u*)(dst + (size_t)rho * Kd + k0 + 8 * ch) = o; }
    asm volatile("s_waitcnt lgkmcnt(0)" ::: "memory");
}
__device__ __forceinline__ void p0_plain(const float* W, int K, int N, bf16_t* WT, LAS float* scr, int r, int lane) {
    const int ng = N / 32, kb = r / ng, g = r % ng;
    p0_item(W, N, 32 * g, 32, 64 * kb, WT + (size_t)(32 * g) * K, K, scr, lane);
}

__device__ __forceinline__ void p0_prologue(Frame& F, const Args& a) {
    LAS float* scr = (LAS float*)(F.lds + RING_OFF + F.wave * 16384);
    const int gw = F.vcu * NWAVES + F.wave, NGW = F.G * NWAVES, lane = F.lane;
    unsigned char* ws = F.ws;
    const float* even_w_in = a.in[4]; const float* even_w_out = a.in[5]; const float* odd_w_in = a.in[9]; const float* odd_w_out = a.in[11];
    const float* moe_g = a.in[16]; const float* moe_u = a.in[17]; const float* moe_d = a.in[18]; const float* ple_proj = a.in[19]; const float* ple_gate = a.in[20];
    constexpr int I_IN0 = 16 * 96, I_OUT = 16 * 32, I_IN1 = 16 * 104, I_PLEG = 16 * 32, I_PLEP = 4 * 32, I_GU = 16 * 32, I_DN = 8 * 32;
    constexpr int I_SMALL = I_IN0 + I_OUT + I_IN1 + I_OUT + 2 * I_PLEG + 2 * I_PLEP, I_MOE = 32 * (I_GU + I_DN), NITEMS = I_SMALL + I_MOE;
    for (int it = gw; it < NITEMS; it += NGW) {
        int r = it;
        if (r < I_IN0) {
            const int kb = r / 96, g = r % 96, pn = g / 8;
            int col0 = 32 * g;
            if (pn == 6 || pn == 7) { const int gl = g % 8, bj = gl / 4, wc = gl % 4; col0 = pn * 256 + 64 * wc + 32 * bj; }
            p0_item(even_w_in, EVEN_IN, col0, 32, 64 * kb, (bf16_t*)(ws + W_IN0) + (size_t)(32 * g) * DM, DM, scr, lane); continue; }
        r -= I_IN0;
        if (r < I_OUT) { p0_plain(even_w_out, DM, DM, (bf16_t*)(ws + W_OUT0), scr, r, lane); continue; } r -= I_OUT;
        if (r < I_IN1) {
            const int kb = r / 104, g = r % 104; int nv = ODD_IN - 32 * g; nv = nv < 0 ? 0 : (nv > 32 ? 32 : nv);
            p0_item(odd_w_in, ODD_IN, 32 * g, nv, 64 * kb, (bf16_t*)(ws + W_IN1) + (size_t)(32 * g) * DM, DM, scr, lane); continue; }
        r -= I_IN1;
        if (r < I_OUT) { p0_plain(odd_w_out, DM, DM, (bf16_t*)(ws + W_OUT1), scr, r, lane); continue; } r -= I_OUT;
        if (r < 2 * I_PLEG) { const int l = r / I_PLEG; p0_plain(ple_gate + (size_t)l * DM * DM, DM, DM, (bf16_t*)(ws + W_PLEG) + (size_t)l * DM * DM, scr, r % I_PLEG, lane); continue; } r -= 2 * I_PLEG;
        if (r < 2 * I_PLEP) { const int l = r / I_PLEP; p0_plain(ple_proj + (size_t)l * 256 * DM, 256, DM, (bf16_t*)(ws + W_PLEP) + (size_t)l * DM * 256, scr, r % I_PLEP, lane); continue; } r -= 2 * I_PLEP;
        {
            const int le = r / (I_GU + I_DN); int q = r % (I_GU + I_DN);
            if (q < I_GU) {
                const int kb = q / 32, g = q % 32, pn = g / 8, gl = g % 8, bj = gl / 4, wc = gl % 4;
                const float* src = (bj == 0 ? moe_g : moe_u) + (size_t)le * DM * 512;
                p0_item(src, 512, 128 * pn + 32 * wc, 32, 64 * kb, (bf16_t*)(ws + W_GU) + (size_t)le * 1024 * 1024 + (size_t)(32 * g) * DM, DM, scr, lane);
            } else { q -= I_GU; p0_plain(moe_d + (size_t)le * 512 * DM, 512, DM, (bf16_t*)(ws + W_DN) + (size_t)le * DM * 512, scr, q, lane); }
        }
    }
    { const float* x = a.in[0]; bf16_t* xb = (bf16_t*)(ws + WS_D);
      for (int m = gw; m < T; m += NGW) { const f32x4* xr = (const f32x4*)(x + (size_t)m * DM) + lane; v2u* o = (v2u*)(xb + (size_t)m * DM) + lane;
#pragma unroll
          for (int j = 0; j < 4; ++j) { const f32x4 v = xr[64 * j]; v2u w; w.x = pk2(v[0], v[1]); w.y = pk2(v[2], v[3]); o[64 * j] = w; } } }
    { const int gt = (F.vcu * NWAVES + F.wave) * 64 + lane, NT = F.G * NWAVES * 64;
      float2* rope = (float2*)(ws + WS_ROPE); float* bt = (float*)(ws + WS_BT); float* lamp = (float*)(ws + WS_LAM);
      for (int g = gt; g < SEQ * 32; g += NT) { const int s = g >> 5, i = g & 31;
          const float inv = (float)pow(10000.0, -(double)i / 32.0); const float ang = (float)s * inv;
          rope[g] = make_float2((float)cos((double)ang), (float)sin((double)ang)); }
      if (gt < 512) { const int h = gt >> 7, dist = gt & 127; int bucket = dist;
          if (dist >= 16) { const int large = 16 + (int)(logf((float)dist / 16.0f) / logf(8.0f) * 16.0f); bucket = large < 31 ? large : 31; }
          bt[gt] = a.in[2][bucket * 4 + h] * LOG2E; }
      if (gt == 0) { const float* lp = a.in[6]; float s01 = 0.f, s23 = 0.f;
          for (int i = 0; i < 64; ++i) { s01 += lp[i] * lp[64 + i]; s23 += lp[128 + i] * lp[192 + i]; }
          lamp[0] = expf(s01) - expf(s23) + 0.2f; } }
}
constexpr int ROWS_PER_WG = 64;
struct TokEP { int e0, p0, e1, p1; };

__device__ __forceinline__ void xreduce32(float (&v)[32], int lane) {
#pragma unroll
    for (int s = 0; s < 5; ++s) {
        const int n = 32 >> s, hn = n >> 1; const bool up = (lane >> s) & 1;
#pragma unroll
        for (int i = 0; i < hn; ++i) { const float a = v[i], b = v[i + hn]; const float send = up ? a : b, keep = up ? b : a; v[i] = keep + __shfl_xor(send, 1 << s); }
    }
    v[0] += __shfl_xor(v[0], 32);
}

__device__ __forceinline__ void ph_ln1_route(Frame& F, const float* xin, const float* __restrict__ MIX, const float* __restrict__ lng, const float* __restrict__ lnb, const float* __restrict__ router_w,
                                             float* H, bf16_t* __restrict__ HB, unsigned* cnt  , TokEP* __restrict__ tok_ep, float2* __restrict__ tok_g, int* __restrict__ list, float* __restrict__ listg) {
    LAS float* rwT = (LAS float*)(F.lds + RING_OFF);
    LAS float* lg = (LAS float*)(F.lds + RING_OFF + 65536) + F.wave * 64;
    LAS int* lcnt = (LAS int*)(F.lds + RING_OFF + 65536 + 2048);
    LAS int* rec = (LAS int*)(F.lds + RING_OFF + 65536 + 2048 + 128);
    int tid_ = threadIdx.x; asm volatile("" : "+v"(tid_));
    const int tid = tid_, lane = tid & 63, wave = F.wave;
    for (int i = tid; i < 16 * DM; i += NWAVES * 64) { const int c = i >> 4, e = i & 15; rwT[e * DM + c] = router_w[i]; }
    if (tid < 32) lcnt[tid] = 0;
    __syncthreads();
    const int row0 = (int)blockIdx.x * ROWS_PER_WG + wave * 8;
    f32x4 gv[4], bv[4];
#pragma unroll
    for (int j = 0; j < 4; ++j) { gv[j] = *((const f32x4*)lng + lane + 64 * j); bv[j] = *((const f32x4*)lnb + lane + 64 * j); }
#pragma nounroll
    for (int batch = 0; batch < 4; ++batch) {
        f32x4 h[2][4];
#pragma unroll
        for (int r = 0; r < 2; ++r) {
            const size_t ro = (size_t)(row0 + batch * 2 + r) * DM;
            float s = 0.f;
#pragma unroll
            for (int j = 0; j < 4; ++j) { const f32x4 xv = *((const f32x4*)(xin + ro) + lane + 64 * j), mv = *((const f32x4*)(MIX + ro) + lane + 64 * j); h[r][j] = xv * ALPHA + mv; s += (h[r][j][0] + h[r][j][1]) + (h[r][j][2] + h[r][j][3]); }
            const float mu = wave_sum(s) * (1.f / DM); float q = 0.f;
#pragma unroll
            for (int j = 0; j < 4; ++j) { h[r][j] = h[r][j] - mu; q += (h[r][j][0] * h[r][j][0] + h[r][j][1] * h[r][j][1]) + (h[r][j][2] * h[r][j][2] + h[r][j][3] * h[r][j][3]); }
            const float rs = rsqrtf(wave_sum(q) * (1.f / DM) + LN_EPS);
#pragma unroll
            for (int j = 0; j < 4; ++j) { h[r][j] = h[r][j] * rs * gv[j] + bv[j];
                *((f32x4*)(H + ro) + lane + 64 * j) = h[r][j];
                v2u w; w.x = pk2(h[r][j][0], h[r][j][1]); w.y = pk2(h[r][j][2], h[r][j][3]); *((v2u*)(HB + ro) + lane + 64 * j) = w; }
        }
        float acc[32];
#pragma unroll
        for (int i = 0; i < 32; ++i) acc[i] = 0.f;
#pragma unroll
        for (int e = 0; e < 16; ++e) {
#pragma unroll
            for (int j = 0; j < 4; ++j) { const f32x4 w = *((const LAS f32x4*)(rwT + e * DM) + lane + 64 * j);
#pragma unroll
                for (int r = 0; r < 2; ++r) acc[r * 16 + e] += (h[r][j][0] * w[0] + h[r][j][1] * w[1]) + (h[r][j][2] * w[2] + h[r][j][3] * w[3]); }
            if ((e & 3) == 3) __builtin_amdgcn_sched_barrier(0);
        }
        xreduce32(acc, lane);
        if (lane < 32) { const int idx = (int)(__builtin_bitreverse32((unsigned)lane) >> 27); lg[idx] = acc[0]; }
        asm volatile("s_waitcnt lgkmcnt(0)" ::: "memory");
        if (lane < 2) {
            float p[16]; float mx = -INFINITY;
#pragma unroll
            for (int e = 0; e < 16; ++e) { p[e] = lg[lane * 16 + e]; mx = fmaxf(mx, p[e]); }
            float sum = 0.f;
#pragma unroll
            for (int e = 0; e < 16; ++e) { p[e] = expf(p[e] - mx); sum += p[e]; }
#pragma unroll
            for (int e = 0; e < 16; ++e) p[e] = p[e] / sum;
            int be0 = 0, be1 = 1; float bs = -1.f, bv0 = 0.f, bv1 = 0.f;
#pragma unroll
            for (int g = 0; g < 4; ++g) {
                int i0 = 0; float v0 = p[4 * g];
#pragma unroll
                for (int j = 1; j < 4; ++j) if (p[4 * g + j] > v0) { v0 = p[4 * g + j]; i0 = j; }
                int i1 = -1; float v1 = -1.f;
#pragma unroll
                for (int j = 0; j < 4; ++j) if (j != i0 && p[4 * g + j] > v1) { v1 = p[4 * g + j]; i1 = j; }
                const float sc = v0 + v1;
                if (sc > bs) { bs = sc; be0 = 4 * g + i0; be1 = 4 * g + i1; bv0 = v0; bv1 = v1; }
            }
            const float g0 = bv0 / (bv0 + bv1), g1 = bv1 / (bv0 + bv1);
            const int lp0 = __hip_atomic_fetch_add(lcnt + be0, 1, __ATOMIC_RELAXED, __HIP_MEMORY_SCOPE_WORKGROUP);
            const int lp1 = __hip_atomic_fetch_add(lcnt + be1, 1, __ATOMIC_RELAXED, __HIP_MEMORY_SCOPE_WORKGROUP);
            LAS int* rc = rec + (wave * 8 + batch * 2 + lane) * 6;
            rc[0] = be0; rc[1] = lp0; rc[2] = be1; rc[3] = lp1; rc[4] = __float_as_int(g0); rc[5] = __float_as_int(g1);
        }
    }
    __syncthreads();
    if (tid < 16) { const int c = lcnt[tid]; lcnt[16 + tid] = c > 0 ? (int)__hip_atomic_fetch_add(cnt + 64 * tid, (unsigned)c, __ATOMIC_RELAXED, __HIP_MEMORY_SCOPE_AGENT) : 0; }
    __syncthreads();
    if (tid < ROWS_PER_WG) {
        const LAS int* rc = rec + tid * 6; const int token = (int)blockIdx.x * ROWS_PER_WG + tid;
        const int e0 = rc[0], e1 = rc[2], p0 = lcnt[16 + e0] + rc[1], p1 = lcnt[16 + e1] + rc[3];
        tok_ep[token] = TokEP{e0, p0, e1, p1}; tok_g[token] = make_float2(__int_as_float(rc[4]), __int_as_float(rc[5]));
        list[e0 * T + p0] = token; list[e1 * T + p1] = token; listg[e0 * T + p0] = __int_as_float(rc[4]); listg[e1 * T + p1] = __int_as_float(rc[5]);
    }
    __syncthreads();
}

__device__ __forceinline__ void moe_tables(Frame& F, const unsigned* cnt) {
    LAS int* tab = (LAS int*)(F.lds + MOE_TAB_OFF);
    if (F.tid == 0) { int off = 0, tb = 0;
        for (int e = 0; e < 16; ++e) { const int c = (int)__hip_atomic_load(cnt + 64 * e, __ATOMIC_RELAXED, __HIP_MEMORY_SCOPE_AGENT); tab[e] = c; tab[16 + e] = off; tab[33 + e] = tb; off += c; tb += (c + 255) >> 8; }
        tab[32] = off; tab[49] = tb; }
    __syncthreads();
}

struct MoeOrder {
    const LAS int* tab; LAS unsigned short* vo; const char* Abase; const char* Bbase; size_t estride, nstride; int G, vcu, arow  ;
    __device__ __forceinline__ bool next(int i, pg8::Unit& u) const {
        const int L = i * G + vcu, total = __builtin_amdgcn_readfirstlane(tab[49]) * 4; if (L >= total) return false;
        const int mt = L >> 2, pn = L & 3; int e = 0;
#pragma unroll
        for (int k = 1; k < 16; ++k) e = (tab[33 + k] <= mt) ? k : e;
        e = __builtin_amdgcn_readfirstlane(e);
        const int m = __builtin_amdgcn_readfirstlane(mt - tab[33 + e]), rows = __builtin_amdgcn_readfirstlane(tab[e] - 256 * m), slot0 = __builtin_amdgcn_readfirstlane(tab[16 + e] + 256 * m);
        u.pn = pn; u.pm = e * T + 256 * m; u.aux = slot0; u.rows = rows < 256 ? rows : 256;
        u.A = Abase + (size_t)slot0 * arow; u.B = Bbase + (size_t)e * estride + (size_t)pn * nstride; return true;
    }
    __device__ __forceinline__ void voff(int i, unsigned (&v)[2][2]) const {
        int tid = threadIdx.x; asm volatile("" : "+v"(tid));
#pragma unroll
        for (int h = 0; h < 2; ++h)
#pragma unroll
            for (int p = 0; p < 2; ++p) { int R, C; pg8::stage_rc(tid * 16 + p * 8192, R, C); v[h][p] = (unsigned)vo[((i * 2 + h) * 2 + p) * 512 + tid] * (unsigned)(DM * 2) + (unsigned)(C * 2); }
    }
    __device__ __forceinline__ void build(const int* __restrict__ list) const {
        const int tid = threadIdx.x; pg8::Unit u;
        for (int i = 0; i < 3; ++i) { if (!next(i, u)) break;
#pragma unroll
            for (int h = 0; h < 2; ++h)
#pragma unroll
                for (int p = 0; p < 2; ++p) { int R, C; pg8::stage_rc(tid * 16 + p * 8192, R, C); const int r = h * 128 + R;
                    vo[((i * 2 + h) * 2 + p) * 512 + tid] = (unsigned short)list[u.pm + (r < u.rows ? r : 0)]; } }
        __syncthreads();
    }
};

namespace pg8 {
struct EpiGateUp {
    bf16_t* ACT;
    __device__ __forceinline__ void operator()(const f32x4 (&acc)[2][2][4][2], const Unit& u, int wr, int wc, int fr, int fq) const {
#pragma unroll
        for (int ai = 0; ai < 2; ++ai)
#pragma unroll
            for (int m = 0; m < 4; ++m) {
                const int r = ai * HALF + wr * 64 + m * 16 + fr;
                if (r < u.rows) {
                    f32x4 o[2];
#pragma unroll
                    for (int n = 0; n < 2; ++n)
#pragma unroll
                        for (int j = 0; j < 4; ++j) o[n][j] = silu_f(acc[ai][0][m][n][j]) * acc[ai][1][m][n][j];
                    *(v4u*)(ACT + (size_t)(u.aux + r) * 512 + u.pn * 128 + 32 * wc + 8 * fq) = pack8(o[0], o[1]);
                }
            }
    }
};
struct EpiDown {
    bf16_t* YS; const float* listg;
    __device__ __forceinline__ void operator()(const f32x4 (&acc)[2][2][4][2], const Unit& u, int wr, int wc, int fr, int fq) const {
#pragma unroll
        for (int ai = 0; ai < 2; ++ai)
#pragma unroll
            for (int m = 0; m < 4; ++m) {
                const int r = ai * HALF + wr * 64 + m * 16 + fr;
                if (r < u.rows) {
                    const float g = listg[u.pm + r];
                    bf16_t* p = YS + (size_t)(u.aux + r) * DM + u.pn * BM + 32 * wc + 8 * fq;
#pragma unroll
                    for (int bj = 0; bj < 2; ++bj) *(v4u*)(p + bj * HALF) = pack8(acc[ai][bj][m][0] * g, acc[ai][bj][m][1] * g);
                }
            }
    }
};
}

__device__ __forceinline__ void ph_ln2(Frame& F, float* H, const bf16_t* __restrict__ YS, const TokEP* __restrict__ tok_ep, const float* __restrict__ lng, const float* __restrict__ lnb, bf16_t* __restrict__ H2B) {
    const LAS int* tab = (const LAS int*)(F.lds + MOE_TAB_OFF);
    int tid_ = threadIdx.x; asm volatile("" : "+v"(tid_));
    const int lane = tid_ & 63, row0 = (int)blockIdx.x * ROWS_PER_WG + F.wave * 8;
    f32x4 gv[4], bv[4];
#pragma unroll
    for (int j = 0; j < 4; ++j) { gv[j] = *((const f32x4*)lng + lane + 64 * j); bv[j] = *((const f32x4*)lnb + lane + 64 * j); }
#pragma nounroll
    for (int r = 0; r < 8; ++r) {
        const int row = row0 + r; const size_t ro = (size_t)row * DM;
        const TokEP ep = tok_ep[row];
        const size_t s0 = (size_t)(tab[16 + ep.e0] + ep.p0) * DM, s1 = (size_t)(tab[16 + ep.e1] + ep.p1) * DM;
        f32x4 v[4]; float s = 0.f;
#pragma unroll
        for (int j = 0; j < 4; ++j) { const f32x4 hv = *((const f32x4*)(H + ro) + lane + 64 * j); const v2u a = *((const v2u*)(YS + s0) + lane + 64 * j), b = *((const v2u*)(YS + s1) + lane + 64 * j);
            const f32x4 ya = {bflo(a.x), bfhi(a.x), bflo(a.y), bfhi(a.y)}, yb = {bflo(b.x), bfhi(b.x), bflo(b.y), bfhi(b.y)};
            v[j] = hv * ALPHA + (ya + yb); s += (v[j][0] + v[j][1]) + (v[j][2] + v[j][3]); }
        const float mu = wave_sum(s) * (1.f / DM); float q = 0.f;
#pragma unroll
        for (int j = 0; j < 4; ++j) { v[j] = v[j] - mu; q += (v[j][0] * v[j][0] + v[j][1] * v[j][1]) + (v[j][2] * v[j][2] + v[j][3] * v[j][3]); }
        const float rs = rsqrtf(wave_sum(q) * (1.f / DM) + LN_EPS);
#pragma unroll
        for (int j = 0; j < 4; ++j) { const f32x4 o = v[j] * rs * gv[j] + bv[j]; *((f32x4*)(H + ro) + lane + 64 * j) = o;
            v2u w; w.x = pk2(o[0], o[1]); w.y = pk2(o[2], o[3]); *((v2u*)(H2B + ro) + lane + 64 * j) = w; }
    }
}
namespace nv {
template <class TA, class TC>
__global__ __launch_bounds__(256) void gemm_nv(const TA* __restrict__ A, int lda, const float* __restrict__ B, int ldb, TC* __restrict__ C, int ldc, int M, int N, int K, float sc, int nsc) {
    __shared__ float As[16][68];
    __shared__ float Bs[16][68];
    const int tid = threadIdx.x, tx = tid & 15, ty = tid >> 4;
    const int m0 = blockIdx.y * 64, n0 = blockIdx.x * 64;
    float acc[4][4];
#pragma unroll
    for (int i = 0; i < 4; ++i)
#pragma unroll
        for (int j = 0; j < 4; ++j) acc[i][j] = 0.f;
    for (int k0 = 0; k0 < K; k0 += 16) {
        { const int r = tid >> 2, c = (tid & 3) * 4; const TA* ap = A + (size_t)(m0 + r) * lda + k0 + c;
          As[c][r] = ldv(ap); As[c + 1][r] = ldv(ap + 1); As[c + 2][r] = ldv(ap + 2); As[c + 3][r] = ldv(ap + 3); }
        { const int r = tid >> 4, c = (tid & 15) * 4, n = n0 + c; float4 v = make_float4(0.f, 0.f, 0.f, 0.f);
          if (n < N) v = *(const float4*)(B + (size_t)(k0 + r) * ldb + n);
          Bs[r][c] = v.x; Bs[r][c + 1] = v.y; Bs[r][c + 2] = v.z; Bs[r][c + 3] = v.w; }
        __syncthreads();
#pragma unroll
        for (int kk = 0; kk < 16; ++kk) {
            float a[4], b[4];
#pragma unroll
            for (int i = 0; i < 4; ++i) a[i] = As[kk][ty * 4 + i];
#pragma unroll
            for (int j = 0; j < 4; ++j) b[j] = Bs[kk][tx * 4 + j];
#pragma unroll
            for (int i = 0; i < 4; ++i)
#pragma unroll
                for (int j = 0; j < 4; ++j) acc[i][j] += a[i] * b[j];
        }
        __syncthreads();
    }
#pragma unroll
    for (int i = 0; i < 4; ++i) { const int m = m0 + ty * 4 + i, n = n0 + tx * 4;
        if (n < N) {
#pragma unroll
            for (int j = 0; j < 4; ++j) stv(C + (size_t)m * ldc + n + j, acc[i][j] * ((n + j) < nsc ? sc : 1.f)); } }
}
template <class TA, class TC>
inline void gemm(hipStream_t st, const TA* A, int lda, const float* B, int ldb, TC* C, int ldc, int M, int N, int K, float sc = 1.f, int nsc = 0) {
    hipLaunchKernelGGL((gemm_nv<TA, TC>), dim3((N + 63) / 64, M / 64), dim3(256), 0, st, A, lda, B, ldb, C, ldc, M, N, K, sc, nsc);
}

__global__ void rope_apply(bf16_t* UB, const float2* rope) {
    const int gid = blockIdx.x * blockDim.x + threadIdx.x;
    if (gid >= T * 4 * 32) return;
    const int i = gid & 31, h = (gid >> 5) & 3, t = gid >> 7, s = t % SEQ;
    const float2 cs = rope[s * 32 + i];
    bf16_t* q = UB + (size_t)t * UBW + 1536 + h * 64; bf16_t* k = UB + (size_t)t * UBW + 1792 + h * 64;
    const float q1 = bf2f(q[i]), q2 = bf2f(q[i + 32]);
    stv(q + i, q1 * cs.x - q2 * cs.y); stv(q + i + 32, q2 * cs.x + q1 * cs.y);
    const float k1 = bf2f(k[i]), k2 = bf2f(k[i + 32]);
    stv(k + i, (k1 * cs.x - k2 * cs.y) * 0.125f); stv(k + i + 32, (k2 * cs.x + k1 * cs.y) * 0.125f);
}

__device__ __forceinline__ float dot64(const float* __restrict__ qs, const bf16_t* __restrict__ kp) {
    float acc = 0.f;
#pragma unroll
    for (int d = 0; d < 64; d += 8) { const v4u w = *(const v4u*)(kp + d);
        acc += qs[d] * bflo(w.x) + qs[d + 1] * bfhi(w.x) + qs[d + 2] * bflo(w.y) + qs[d + 3] * bfhi(w.y) + qs[d + 4] * bflo(w.z) + qs[d + 5] * bfhi(w.z) + qs[d + 6] * bflo(w.w) + qs[d + 7] * bfhi(w.w); }
    return acc;
}

__global__ __launch_bounds__(64) void diff_attn_nv(const bf16_t* __restrict__ UB, bf16_t* __restrict__ Y, const float* __restrict__ bt, const float* __restrict__ lamp, const float* __restrict__ diff_g) {
    __shared__ float sc1[SEQ];
    __shared__ float sc2[SEQ];
    __shared__ float qs[128];
    const int lane = threadIdx.x;
    const int idx = blockIdx.x, q = idx % SEQ, h = (idx / SEQ) % 4, b = idx / (SEQ * 4);
    const bf16_t* Ub = UB + (size_t)b * SEQ * UBW;
    qs[lane] = bf2f(Ub[(size_t)q * UBW + h * 128 + lane]); qs[lane + 64] = bf2f(Ub[(size_t)q * UBW + h * 128 + 64 + lane]);
    __syncthreads();
    const float lam = lamp[0];
    float m1 = -INFINITY, m2 = -INFINITY;
    for (int k = lane; k <= q; k += 64) {
        const bf16_t* kp = Ub + (size_t)k * UBW + 512 + h * 128;
        int dist = q - k; if (dist > 127) dist = 127;
        const float bias = bt[h * 128 + dist];
        const float s1 = dot64(qs, kp) + bias, s2 = dot64(qs + 64, kp + 64) + bias;
        sc1[k] = s1; sc2[k] = s2; m1 = fmaxf(m1, s1); m2 = fmaxf(m2, s2);
    }
    m1 = wave_max(m1); m2 = wave_max(m2);
    float l1 = 0.f, l2 = 0.f;
    for (int k = lane; k <= q; k += 64) { const float e1 = exp2f(sc1[k] - m1), e2 = exp2f(sc2[k] - m2); sc1[k] = e1; sc2[k] = e2; l1 += e1; l2 += e2; }
    l1 = wave_sum(l1); l2 = wave_sum(l2);
    const float r1 = 1.f / l1, r2 = lam / l2;
    for (int k = lane; k <= q; k += 64) sc1[k] = sc1[k] * r1 - sc2[k] * r2;
    __syncthreads();
    float a0 = 0.f, a1 = 0.f;
    const bf16_t* vp = Ub + 1024 + h * 128 + lane;
    for (int k = 0; k <= q; ++k) { const float a = sc1[k]; a0 += a * bf2f(vp[(size_t)k * UBW]); a1 += a * bf2f(vp[(size_t)k * UBW + 64]); }
    const float ss = wave_sum(a0 * a0 + a1 * a1);
    const float r = rsqrtf(ss * (1.f / 128.f) + LN_EPS) * 0.8f;
    bf16_t* yp = Y + (size_t)(b * SEQ + q) * DM + h * 128;
    stv(yp + lane, a0 * r * diff_g[lane]); stv(yp + lane + 64, a1 * r * diff_g[lane + 64]);
}

__global__ __launch_bounds__(64) void retention_nv(const bf16_t* __restrict__ UB, bf16_t* __restrict__ Y, const float* __restrict__ ret_g) {
    __shared__ float sc[SEQ];
    __shared__ float qs[64];
    const int lane = threadIdx.x;
    const int idx = blockIdx.x, t = idx % SEQ, h = (idx / SEQ) % 4, b = idx / (SEQ * 4);
    const bf16_t* Ub = UB + (size_t)b * SEQ * UBW;
    qs[lane] = bf2f(Ub[(size_t)t * UBW + 1536 + h * 64 + lane]);
    __syncthreads();
    const float log_g = log1pf(-exp2f(-5.0f - (float)h));
    for (int k = lane; k <= t; k += 64) sc[k] = dot64(qs, Ub + (size_t)k * UBW + 1792 + h * 64) * expf((float)(t - k) * log_g);
    __syncthreads();
    float a0 = 0.f, a1 = 0.f;
    const bf16_t* vp = Ub + 2048 + h * 128 + lane;
    for (int k = 0; k <= t; ++k) { const float a = sc[k]; a0 += a * bf2f(vp[(size_t)k * UBW]); a1 += a * bf2f(vp[(size_t)k * UBW + 64]); }
    const float mu = wave_sum(a0 + a1) * (1.f / 128.f);
    const float d0 = a0 - mu, d1 = a1 - mu;
    const float var = wave_sum(d0 * d0 + d1 * d1) * (1.f / 128.f);
    const float r = rsqrtf(var + LN_EPS);
    const bf16_t* gp = Ub + (size_t)t * UBW + 2560 + h * 128;
    const float g0 = bf2f(gp[lane]), g1 = bf2f(gp[lane + 64]);
    bf16_t* yp = Y + (size_t)(b * SEQ + t) * DM + 512 + h * 128;
    stv(yp + lane, silu_f(g0) * (d0 * r * ret_g[lane])); stv(yp + lane + 64, silu_f(g1) * (d1 * r * ret_g[lane + 64]));
}

template <class TB>
__global__ __launch_bounds__(256) void ln_nv(const float* a, const TB* __restrict__ bsrc, const float* __restrict__ g, const float* __restrict__ beta, float* out, bf16_t* __restrict__ outb) {
    const int lane = threadIdx.x & 63, row = blockIdx.x * 4 + (threadIdx.x >> 6);
    float v[16]; float s = 0.f;
#pragma unroll
    for (int j = 0; j < 16; ++j) { const int c = lane + 64 * j; v[j] = ALPHA * a[(size_t)row * DM + c] + ldv(bsrc + (size_t)row * DM + c); s += v[j]; }
    const float mu = wave_sum(s) * (1.f / DM);
    float q = 0.f;
#pragma unroll
    for (int j = 0; j < 16; ++j) { v[j] -= mu; q += v[j] * v[j]; }
    const float r = rsqrtf(wave_sum(q) * (1.f / DM) + LN_EPS);
#pragma unroll
    for (int j = 0; j < 16; ++j) { const int c = lane + 64 * j; const float o = v[j] * r * g[c] + beta[c]; out[(size_t)row * DM + c] = o; stv(outb + (size_t)row * DM + c, o); }
}

__global__ __launch_bounds__(256) void moe_nv(const float* __restrict__ H, const float* __restrict__ router_w, const float* __restrict__ Wg, const float* __restrict__ Wu, const float* __restrict__ Wd, float* __restrict__ F) {
    __shared__ float hs[DM];
    __shared__ float as[512];
    __shared__ float logit[16];
    __shared__ float p[16];
    __shared__ int sel_e[2];
    __shared__ float sel_g[2];
    const int tid = threadIdx.x, lane = tid & 63, w = tid >> 6, tok = blockIdx.x;
    for (int c = tid; c < DM; c += 256) hs[c] = H[(size_t)tok * DM + c];
    __syncthreads();
    for (int e = w * 4; e < w * 4 + 4; ++e) { float s = 0.f; for (int k = lane; k < DM; k += 64) s += hs[k] * router_w[k * 16 + e]; s = wave_sum(s); if (lane == 0) logit[e] = s; }
    __syncthreads();
    if (tid == 0) {
        float mx = -INFINITY; for (int e = 0; e < 16; ++e) mx = fmaxf(mx, logit[e]);
        float sum = 0.f; for (int e = 0; e < 16; ++e) { p[e] = expf(logit[e] - mx); sum += p[e]; }
        for (int e = 0; e < 16; ++e) p[e] /= sum;
        int best = 0; float bs = -1.f; int bi0 = 0, bi1 = 1;
        for (int g = 0; g < 4; ++g) {
            int i0 = 0; for (int j = 1; j < 4; ++j) if (p[g * 4 + j] > p[g * 4 + i0]) i0 = j;
            int i1 = (i0 == 0) ? 1 : 0; for (int j = 0; j < 4; ++j) if (j != i0 && p[g * 4 + j] > p[g * 4 + i1]) i1 = j;
            const float sc = p[g * 4 + i0] + p[g * 4 + i1];
            if (sc > bs) { bs = sc; best = g; bi0 = i0; bi1 = i1; }
        }
        const float v0 = p[best * 4 + bi0], v1 = p[best * 4 + bi1];
        sel_e[0] = best * 4 + bi0; sel_e[1] = best * 4 + bi1; sel_g[0] = v0 / (v0 + v1); sel_g[1] = v1 / (v0 + v1);
    }
    __syncthreads();
    float y[4] = {0.f, 0.f, 0.f, 0.f};
    for (int kk = 0; kk < 2; ++kk) {
        const int e = sel_e[kk]; const float gt = sel_g[kk];
        const float* wg = Wg + (size_t)e * DM * 512; const float* wu = Wu + (size_t)e * DM * 512; const float* wd = Wd + (size_t)e * 512 * DM;
        float g0 = 0.f, g1 = 0.f, u0 = 0.f, u1 = 0.f;
        for (int k = 0; k < DM; ++k) { const float hv = hs[k];
            g0 += hv * wg[(size_t)k * 512 + tid]; g1 += hv * wg[(size_t)k * 512 + tid + 256]; u0 += hv * wu[(size_t)k * 512 + tid]; u1 += hv * wu[(size_t)k * 512 + tid + 256]; }
        __syncthreads();
        as[tid] = (g0 / (1.f + expf(-g0))) * u0; as[tid + 256] = (g1 / (1.f + expf(-g1))) * u1;
        __syncthreads();
        float o0 = 0.f, o1 = 0.f, o2 = 0.f, o3 = 0.f;
        for (int k = 0; k < 512; ++k) { const float av = as[k];
            o0 += av * wd[(size_t)k * DM + tid]; o1 += av * wd[(size_t)k * DM + tid + 256]; o2 += av * wd[(size_t)k * DM + tid + 512]; o3 += av * wd[(size_t)k * DM + tid + 768]; }
        y[0] += gt * o0; y[1] += gt * o1; y[2] += gt * o2; y[3] += gt * o3;
    }
#pragma unroll
    for (int j = 0; j < 4; ++j) F[(size_t)tok * DM + tid + 256 * j] = y[j];
}

__global__ void ple_final(const float* Hh, const float* __restrict__ G, const bf16_t* __restrict__ PP, float* out, bf16_t* __restrict__ outb, int n) {
    const int gid = blockIdx.x * blockDim.x + threadIdx.x;
    if (gid >= n) return;
    const float o = Hh[gid] + sigmoid_f(G[gid]) * bf2f(PP[gid]);
    out[gid] = o; stv(outb + gid, o);
}

__global__ void fox_cum(const float* __restrict__ LF, const float* __restrict__ bf, float* __restrict__ cum) {
    const int gid = blockIdx.x * blockDim.x + threadIdx.x;
    if (gid >= BATCH * 16) return;
    const int h = gid & 15, b = gid >> 4;
    float c = 0.f;
    for (int s = 0; s < SEQ; ++s) { const float z = LF[(size_t)(b * SEQ + s) * 16 + h] + bf[h]; c += fminf(z, 0.f) - log1pf(expf(-fabsf(z))); cum[(size_t)gid * SEQ + s] = c * LOG2E; }
}
__global__ __launch_bounds__(64) void fox_attn_nv(const bf16_t* __restrict__ UB, const float* __restrict__ cum, bf16_t* __restrict__ Y) {
    __shared__ float sc[SEQ];
    __shared__ float qs[64];
    const int lane = threadIdx.x;
    const int idx = blockIdx.x, q = idx % SEQ, h = (idx / SEQ) % 16, b = idx / (SEQ * 16);
    const bf16_t* Ub = UB + (size_t)b * SEQ * UBW;
    const float* cb = cum + (size_t)(b * 16 + h) * SEQ;
    qs[lane] = bf2f(Ub[(size_t)q * UBW + h * 64 + lane]);
    __syncthreads();
    const float cq = cb[q];
    float m = -INFINITY;
    for (int k = lane; k <= q; k += 64) { const float s = dot64(qs, Ub + (size_t)k * UBW + 1024 + h * 64) + cq - cb[k]; sc[k] = s; m = fmaxf(m, s); }
    m = wave_max(m);
    float l = 0.f;
    for (int k = lane; k <= q; k += 64) { const float e = exp2f(sc[k] - m); sc[k] = e; l += e; }
    l = wave_sum(l);
    __syncthreads();
    float a0 = 0.f;
    const bf16_t* vp = Ub + 2048 + h * 64 + lane;
    for (int k = 0; k <= q; ++k) a0 += sc[k] * bf2f(vp[(size_t)k * UBW]);
    stv(Y + (size_t)(b * SEQ + q) * DM + h * 64 + lane, a0 / l);
}
__global__ __launch_bounds__(256) void moe_slots_nv(const bf16_t* __restrict__ HB, const unsigned* __restrict__ cnt, const int* __restrict__ list, const float* __restrict__ listg,
                                                     const float* __restrict__ Wg, const float* __restrict__ Wu, const float* __restrict__ Wd, bf16_t* __restrict__ YS) {
    __shared__ float hs[DM];
    __shared__ float as[512];
    const int tid = threadIdx.x, slot = blockIdx.x;
    int e = 0, off = 0;
    for (int k = 0; k < 16; ++k) { const int c = (int)cnt[64 * k]; if (slot >= off + c) { off += c; e = k + 1; } else break; }
    if (e >= 16) return;
    const int pos = slot - off, token = list[e * T + pos]; const float gt = listg[e * T + pos];
    for (int c = tid; c < DM; c += 256) hs[c] = bf2f(HB[(size_t)token * DM + c]);
    __syncthreads();
    const float* wg = Wg + (size_t)e * DM * 512; const float* wu = Wu + (size_t)e * DM * 512; const float* wd = Wd + (size_t)e * 512 * DM;
    float g0 = 0.f, g1 = 0.f, u0 = 0.f, u1 = 0.f;
    for (int k = 0; k < DM; ++k) { const float hv = hs[k];
        g0 += hv * wg[(size_t)k * 512 + tid]; g1 += hv * wg[(size_t)k * 512 + tid + 256]; u0 += hv * wu[(size_t)k * 512 + tid]; u1 += hv * wu[(size_t)k * 512 + tid + 256]; }
    as[tid] = silu_f(g0) * u0; as[tid + 256] = silu_f(g1) * u1;
    __syncthreads();
    float o0 = 0.f, o1 = 0.f, o2 = 0.f, o3 = 0.f;
    for (int k = 0; k < 512; ++k) { const float av = as[k];
        o0 += av * wd[(size_t)k * DM + tid]; o1 += av * wd[(size_t)k * DM + tid + 256]; o2 += av * wd[(size_t)k * DM + tid + 512]; o3 += av * wd[(size_t)k * DM + tid + 768]; }
    bf16_t* y = YS + (size_t)slot * DM;
    stv(y + tid, gt * o0); stv(y + tid + 256, gt * o1); stv(y + tid + 512, gt * o2); stv(y + tid + 768, gt * o3);
}
}
constexpr int NPH = 19;
#ifndef MEGA_MASK
#define MEGA_MASK 0x3
#endif
__host__ __device__ constexpr bool is_mega(int ph) { return ((MEGA_MASK >> ph) & 1) != 0; }

__global__ void __launch_bounds__(NWAVES * 64, 2) mega_fwd(Args args) {
    extern __shared__ __attribute__((aligned(16))) unsigned char lds[];
    Frame F;
    F.lds = (LAS unsigned char*)lds;
    F.MISC = (volatile LAS unsigned*)(F.lds + MISC_OFF);
    F.tid = threadIdx.x; F.lane = F.tid & 63; F.wave = __builtin_amdgcn_readfirstlane(F.tid >> 6);
    F.G = gridDim.x; { const int bx = blockIdx.x; F.vcu = (F.G % 8 == 0) ? (bx % 8) * (F.G / 8) + bx / 8 : bx; }
    F.ws = args.ws; F.ctl = (unsigned*)(args.ws + WS_CTL);
    for (int u = F.tid; u < (LDS_BYTES - LDSCTL_OFF) / 4; u += NWAVES * 64) ((LAS unsigned*)(F.lds + LDSCTL_OFF))[u] = 0u;
    __syncthreads();
    const int lo = args.ph_lo, hi = args.ph_hi;
    XcdBarrier bar; bar.bar = F.ctl + CW_BAR + args.li * XCD_BAR_WORDS; bar.x = 0; bar.st = nullptr;
    if (hi - lo > 1) bar = xcd_barrier_post(F.ctl + CW_BAR + args.li * XCD_BAR_WORDS, F.MISC + 8);
#define GRID_BAR() xcd_barrier(bar)
    if constexpr (is_mega(0)) { if (lo == 0) { F.ws = args.ws; p0_prologue(F, args); if (hi > 1) GRID_BAR(); } }
#pragma nounroll
    for (int ph = (lo == 0 ? 1 : lo); ph < hi; ++ph) {
        { int t_ = threadIdx.x; asm volatile("" : "+v"(t_)); F.tid = t_; F.lane = t_ & 63; }
        unsigned char* ws = args.ws; asm volatile("" : "+s"(ws)); F.ws = ws; F.ctl = (unsigned*)(ws + WS_CTL);
        const int layer = ph >= 10 ? 1 : 0, q = ph >= 10 ? ph - 9 : ph;
        unsigned* cnt = F.ctl + CW_CNT + layer * 16 * 64;
        TokEP* tok_ep = (TokEP*)(ws + WS_TOK); float2* tok_g = (float2*)(ws + WS_TOK + 512 * 1024); int* list = (int*)(ws + WS_LIST); float* listg = (float*)(ws + WS_LISTG);
        if (q == 1) {
            if (layer == 0) { if constexpr (is_mega(1)) {
                pg8::DenseOrder S; S.init(ws + WS_D, ws + W_IN0, T, EVEN_IN, DM, F.G, (int)blockIdx.x);
                pg8::EpiIn0 E{(bf16_t*)(ws + WS_A), (const float2*)(ws + WS_ROPE)};
                pg8::gemm_phase<pg8::EpiIn0, pg8::DenseOrder, true, false>(F.lds + RING_OFF, DM, S, E); }
            } else { if constexpr (is_mega(10)) {
                pg8::DenseOrder S; S.init(ws + WS_D, ws + W_IN1, T, 3328, DM, F.G, (int)blockIdx.x);
                pg8::EpiIn1 E{(bf16_t*)(ws + WS_A), (float*)(ws + WS_LF)};
                pg8::gemm_phase<pg8::EpiIn1, pg8::DenseOrder, true, false>(F.lds + RING_OFF, DM, S, E); }
            }
        } else if (q == 4) { if constexpr (is_mega(4)) {
            { const float* p = args.in[1] + (size_t)layer * T * 256; bf16_t* pb = (bf16_t*)(ws + WS_D); const int gw = F.vcu * NWAVES + F.wave, NGW = F.G * NWAVES;
              for (int m = gw; m < T; m += NGW) { const f32x4 v = *((const f32x4*)(p + (size_t)m * 256) + F.lane); v2u w; w.x = pk2(v[0], v[1]); w.y = pk2(v[2], v[3]); *((v2u*)(pb + (size_t)m * 256) + F.lane) = w; } }
            pg8::DenseOrder S; S.init(ws + WS_B, ws + (layer == 0 ? W_OUT0 : W_OUT1), T, DM, DM, F.G, (int)blockIdx.x);
            pg8::EpiF32 E{(float*)(ws + WS_A), DM};
            pg8::gemm_phase<pg8::EpiF32, pg8::DenseOrder, false, false>(F.lds + RING_OFF, DM, S, E); }
        } else if (q == 5) { if constexpr (is_mega(5)) {
            ph_ln1_route(F, layer == 0 ? args.in[0] : args.out, (const float*)(ws + WS_A), args.in[12] + layer * DM, args.in[13] + layer * DM, args.in[3], args.out, (bf16_t*)(ws + WS_B), cnt, tok_ep, tok_g, list, listg); }
        } else if (q == 6) { if constexpr (is_mega(6)) {
            moe_tables(F, cnt);
            MoeOrder S{(const LAS int*)(F.lds + MOE_TAB_OFF), (LAS unsigned short*)(F.lds + VOFF_OFF), (const char*)(ws + WS_B), (const char*)(ws + W_GU) + (size_t)layer * 32 * MiB, 2 * MiB, 512 * 1024, F.G, F.vcu, 0};
            S.build(list);
            pg8::EpiGateUp E{(bf16_t*)(ws + WS_ACT)};
            pg8::gemm_phase<pg8::EpiGateUp, MoeOrder, true, true>(F.lds + RING_OFF, DM, S, E);
            pg8::DenseOrder S2; S2.init(ws + WS_D, ws + W_PLEP + (size_t)layer * 512 * 1024, T, DM, 256, F.G, (int)blockIdx.x);
            pg8::EpiBf16 E2{(bf16_t*)(ws + WS_PP), DM};
            pg8::gemm_phase<pg8::EpiBf16, pg8::DenseOrder, false, false>(F.lds + RING_OFF, 256, S2, E2); }
        } else if (q == 7) { if constexpr (is_mega(7)) {
            moe_tables(F, cnt);
            MoeOrder S{(const LAS int*)(F.lds + MOE_TAB_OFF), (LAS unsigned short*)(F.lds + VOFF_OFF), (const char*)(ws + WS_ACT), (const char*)(ws + W_DN) + (size_t)layer * 16 * MiB, 1 * MiB, 256 * 1024, F.G, F.vcu, 1024};
            pg8::EpiDown E{(bf16_t*)(ws + WS_YS), listg};
            pg8::gemm_phase<pg8::EpiDown, MoeOrder, true, false>(F.lds + RING_OFF, 512, S, E); }
        } else if (q == 8) { if constexpr (is_mega(8)) {
            moe_tables(F, cnt);
            ph_ln2(F, args.out, (const bf16_t*)(ws + WS_YS), tok_ep, args.in[14] + layer * DM, args.in[15] + layer * DM, (bf16_t*)(ws + WS_B)); }
        } else if (q == 9) { if constexpr (is_mega(9)) {
            pg8::DenseOrder S; S.init(ws + WS_B, ws + W_PLEG + (size_t)layer * 2 * MiB, T, DM, DM, F.G, (int)blockIdx.x);
            pg8::EpiPle E{args.out, (const bf16_t*)(ws + WS_PP), (bf16_t*)(ws + WS_D)};
            pg8::gemm_phase<pg8::EpiPle, pg8::DenseOrder, false, false>(F.lds + RING_OFF, DM, S, E); }
        }
        if (ph + 1 < hi) GRID_BAR();
    }
#undef GRID_BAR
}

static void launch_mega(int lo, int hi, int li, int grid, void* const* d_in, void* d_out, void* d_ws, hipStream_t stream) {
    Args a{};
    for (int i = 0; i < 21; ++i) a.in[i] = (const float*)d_in[i];
    a.out = (float*)d_out; a.ws = (unsigned char*)d_ws; a.ph_lo = lo; a.ph_hi = hi; a.li = li; a.pad = 0;
    void* kargs[] = {&a};
    const hipError_t e = hipLaunchCooperativeKernel((const void*)mega_fwd, dim3(grid), dim3(NWAVES * 64), kargs, LDS_BYTES, stream);
    if (e != hipSuccess) fprintf(stderr, "kernel_launch: cooperative launch of phases [%d,%d) failed: %s (grid %d)\n", lo, hi, hipGetErrorString(e), grid);
}

static void naive_phase(int ph, void* const* d_in, void* d_out, void* d_ws, hipStream_t st) {
    using namespace nv;
    unsigned char* ws = (unsigned char*)d_ws;
    const float* x = (const float*)d_in[0]; const float* p = (const float*)d_in[1]; const float* router_w = (const float*)d_in[3];
    const float* even_w_in = (const float*)d_in[4]; const float* even_w_out = (const float*)d_in[5];
    const float* diff_g = (const float*)d_in[7]; const float* ret_g = (const float*)d_in[8];
    const float* odd_w_in = (const float*)d_in[9]; const float* odd_bf = (const float*)d_in[10]; const float* odd_w_out = (const float*)d_in[11];
    const float* ln_mix_g = (const float*)d_in[12]; const float* ln_mix_b = (const float*)d_in[13]; const float* ln_ffn_g = (const float*)d_in[14]; const float* ln_ffn_b = (const float*)d_in[15];
    const float* moe_g = (const float*)d_in[16]; const float* moe_u = (const float*)d_in[17]; const float* moe_d = (const float*)d_in[18];
    const float* ple_proj = (const float*)d_in[19]; const float* ple_gate = (const float*)d_in[20];
    float* out = (float*)d_out;
    bf16_t* UB = (bf16_t*)(ws + WS_A); float* MIX = (float*)(ws + WS_A); float* FFN = (float*)(ws + WS_A); float* G = (float*)(ws + WS_A);
    bf16_t* Y = (bf16_t*)(ws + WS_B); bf16_t* HB = (bf16_t*)(ws + WS_B); bf16_t* XB = (bf16_t*)(ws + WS_D); bf16_t* PP = (bf16_t*)(ws + WS_PP);
    const float2* rope = (const float2*)(ws + WS_ROPE); const float* bt = (const float*)(ws + WS_BT); const float* lamp = (const float*)(ws + WS_LAM);
    float* cum = (float*)(ws + WS_CUM); float* LF = (float*)(ws + WS_LF);
    const int layer = ph >= 10 ? 1 : 0; const int q = ph >= 10 ? ph - 9 : ph;
    const size_t TD = (size_t)T * DM;
    switch (q) {
    case 1:
        if (layer == 0) { gemm<float, bf16_t>(st, x, DM, even_w_in, EVEN_IN, UB, UBW, T, EVEN_IN, DM, SCQ, 512);
                          hipLaunchKernelGGL(rope_apply, dim3(T * 4 * 32 / 256), dim3(256), 0, st, UB, rope); }
        else { gemm<bf16_t, bf16_t>(st, XB, DM, odd_w_in, ODD_IN, UB, UBW, T, 3072, DM, SCQ, 1024);
               gemm<bf16_t, float>(st, XB, DM, odd_w_in + 3072, ODD_IN, LF, 16, T, 16, DM);
             }
        break;
    case 2:
        if (layer == 0) hipLaunchKernelGGL(diff_attn_nv, dim3(BATCH * 4 * SEQ), dim3(64), 0, st, UB, Y, bt, lamp, diff_g);
        else hipLaunchKernelGGL(fox_cum, dim3(1), dim3(128), 0, st, LF, odd_bf, cum);
        break;
    case 3:
        if (layer == 0) hipLaunchKernelGGL(retention_nv, dim3(BATCH * 4 * SEQ), dim3(64), 0, st, UB, Y, ret_g);
        else hipLaunchKernelGGL(fox_attn_nv, dim3(BATCH * 16 * SEQ), dim3(64), 0, st, UB, cum, Y);
        break;
    case 4: gemm<bf16_t, float>(st, Y, DM, layer == 0 ? even_w_out : odd_w_out, DM, MIX, DM, T, DM, DM); break;
    case 5: hipLaunchKernelGGL((ln_nv<float>), dim3(T / 4), dim3(256), 0, st, layer == 0 ? x : out, MIX, ln_mix_g + layer * DM, ln_mix_b + layer * DM, out, HB); break;
    case 6:
#ifdef DIAG_SLOTS
        if (layer == 0) {
        hipLaunchKernelGGL(moe_slots_nv, dim3(2 * T), dim3(256), 0, st, HB, (const unsigned*)(ws + WS_CTL) + CW_CNT + layer * 16 * 64, (const int*)(ws + WS_LIST), (const float*)(ws + WS_LISTG),
                           moe_g + (size_t)layer * 16 * DM * 512, moe_u + (size_t)layer * 16 * DM * 512, moe_d + (size_t)layer * 16 * 512 * DM, (bf16_t*)(ws + WS_YS));
        gemm<float, bf16_t>(st, p + (size_t)layer * T * 256, 256, ple_proj + (size_t)layer * 256 * DM, DM, PP, DM, T, DM, 256);
        break; }
#endif
        hipLaunchKernelGGL(moe_nv, dim3(T), dim3(256), 0, st, out, router_w, moe_g + (size_t)layer * 16 * DM * 512, moe_u + (size_t)layer * 16 * DM * 512, moe_d + (size_t)layer * 16 * 512 * DM, FFN);
        gemm<float, bf16_t>(st, p + (size_t)layer * T * 256, 256, ple_proj + (size_t)layer * 256 * DM, DM, PP, DM, T, DM, 256);
        break;
    case 7: break;
    case 8: hipLaunchKernelGGL((ln_nv<float>), dim3(T / 4), dim3(256), 0, st, out, FFN, ln_ffn_g + layer * DM, ln_ffn_b + layer * DM, out, HB); break;
    case 9:
        gemm<bf16_t, float>(st, HB, DM, ple_gate + (size_t)layer * DM * DM, DM, G, DM, T, DM, DM);
        hipLaunchKernelGGL(ple_final, dim3((int)(TD / 256)), dim3(256), 0, st, out, G, PP, out, XB, (int)TD);
        break;
    }
}

extern "C" void kernel_launch(void* const* d_in, const int* in_sizes, int n_in, void* d_out, int out_size, void* d_ws, size_t ws_size, hipStream_t stream) {
    static int grid = 0;
    if (grid == 0) {
        if (n_in != 21 || in_sizes[0] != T * DM || out_size != T * DM || ws_size < WS_END) {
            fprintf(stderr, "kernel_launch: unexpected problem (n_in %d, in0 %d, out %d, ws %zu < %zu); nothing launched\n", n_in, n_in > 0 ? in_sizes[0] : -1, out_size, ws_size, (size_t)WS_END); grid = -1; return; }
        int dev = 0, cus = 0, per_cu = 0;
        if (hipGetDevice(&dev) != hipSuccess || hipDeviceGetAttribute(&cus, hipDeviceAttributeMultiprocessorCount, dev) != hipSuccess) { grid = -1; return; }
        if (hipFuncSetAttribute((const void*)mega_fwd, hipFuncAttributeMaxDynamicSharedMemorySize, LDS_BYTES) != hipSuccess) { fprintf(stderr, "kernel_launch: hipFuncSetAttribute failed\n"); grid = -1; return; }
        if (hipOccupancyMaxActiveBlocksPerMultiprocessor(&per_cu, (const void*)mega_fwd, NWAVES * 64, LDS_BYTES) != hipSuccess || per_cu < 1) {
            fprintf(stderr, "kernel_launch: occupancy query says %d workgroups per CU; nothing launched\n", per_cu); grid = -1; return; }
        (void)hipGetLastError();
        grid = cus;
    }
    if (grid < 0) return;
    if (grid != 256) { fprintf(stderr, "kernel_launch: this kernel is laid out for 256 CUs (got %d); nothing launched\n", grid); return; }
    (void)hipMemsetAsync((char*)d_ws + WS_CTL, 0, CTL_ZERO_BYTES, stream);
    int li = 0, lo = -1;
    for (int ph = 0; ph <= NPH; ++ph) {
        const bool mg = ph < NPH && is_mega(ph);
        if (mg) { if (lo < 0) lo = ph; continue; }
        if (lo >= 0) { launch_mega(lo, ph, li++, grid, d_in, d_out, d_ws, stream); lo = -1; }
        if (ph < NPH) naive_phase(ph, d_in, d_out, d_ws, stream);
    }
}
```

```cpp
#include <hip/hip_runtime.h>
#include <cstdio>
#include <cstdint>
#include <cmath>

constexpr int BATCH = 8, SEQ = 2048, DM = 1024, T = BATCH * SEQ;
constexpr int EVEN_IN = 3072, ODD_IN = 3088, UBW = 3072;
constexpr float LN_EPS = 1e-5f;
constexpr float ALPHA = 1.41421356237309515f;
constexpr float LOG2E = 1.4426950408889634f;
constexpr float SCQ = 0.125f * LOG2E;

typedef unsigned short bf16_t;
#define GAS __attribute__((address_space(1)))
#define LAS __attribute__((address_space(3)))
typedef unsigned v4u __attribute__((ext_vector_type(4)));
typedef unsigned v2u __attribute__((ext_vector_type(2)));
typedef float f32x4 __attribute__((ext_vector_type(4)));
typedef float f32x16 __attribute__((ext_vector_type(16)));
typedef short bf16x8 __attribute__((ext_vector_type(8)));
typedef short s16x4 __attribute__((ext_vector_type(4)));

__device__ __forceinline__ unsigned f2bf(float f) { unsigned u = __builtin_bit_cast(unsigned, f); return (u + 0x7fffu + ((u >> 16) & 1u)) >> 16; }
__device__ __forceinline__ unsigned pk2(float lo, float hi) { return f2bf(lo) | (f2bf(hi) << 16); }
__device__ __forceinline__ float bf2f(bf16_t h) { return __builtin_bit_cast(float, (unsigned)h << 16); }
__device__ __forceinline__ float bflo(unsigned w) { return __builtin_bit_cast(float, w << 16); }
__device__ __forceinline__ float bfhi(unsigned w) { return __builtin_bit_cast(float, w & 0xffff0000u); }
__device__ __forceinline__ float ldv(const float* p) { return *p; }
__device__ __forceinline__ float ldv(const bf16_t* p) { return bf2f(*p); }
__device__ __forceinline__ void stv(float* p, float v) { *p = v; }
__device__ __forceinline__ void stv(bf16_t* p, float v) { *p = (bf16_t)f2bf(v); }
__device__ __forceinline__ float wave_sum(float v) {
#pragma unroll
    for (int o = 1; o < 64; o <<= 1) v += __shfl_xor(v, o);
    return v;
}
__device__ __forceinline__ float wave_max(float v) {
#pragma unroll
    for (int o = 1; o < 64; o <<= 1) v = fmaxf(v, __shfl_xor(v, o));
    return v;
}
__device__ __forceinline__ float silu_f(float g) { return g / (1.f + __expf(-g)); }
__device__ __forceinline__ float sigmoid_f(float g) { return 1.f / (1.f + __expf(-g)); }

constexpr size_t MiB = 1u << 20;
constexpr size_t WS_CTL = 0, CTL_ZERO_BYTES = 1 * MiB;
constexpr size_t WS_ROPE = 1 * MiB;
constexpr size_t WS_BT = 1 * MiB + 512 * 1024;
constexpr size_t WS_LAM = WS_BT + 4096;
constexpr size_t WS_CUM = 2 * MiB;
constexpr size_t WS_LF = 3 * MiB;
constexpr size_t WS_TOK = 4 * MiB;
constexpr size_t WS_LIST = 5 * MiB;
constexpr size_t WS_LISTG = 6 * MiB;
constexpr size_t WS_W = 9 * MiB;
constexpr size_t W_IN0 = WS_W, W_OUT0 = W_IN0 + 6 * MiB, W_IN1 = W_OUT0 + 2 * MiB, W_OUT1 = W_IN1 + 6 * MiB + 512 * 1024;
constexpr size_t W_PLEG = W_OUT1 + 2 * MiB, W_PLEP = W_PLEG + 4 * MiB, W_GU = W_PLEP + 1 * MiB, W_DN = W_GU + 64 * MiB, W_END = W_DN + 32 * MiB;
static_assert(W_END == 126 * MiB + 512 * 1024, "weights map");
constexpr size_t WS_A = 127 * MiB;
constexpr size_t WS_YS = WS_A, WS_ACT = WS_A + 64 * MiB;
constexpr size_t WS_B = 224 * MiB;
constexpr size_t WS_D = 256 * MiB;
constexpr size_t WS_PP = 288 * MiB;
constexpr size_t WS_END = 320 * MiB;
constexpr int CW_TMO = 0, CW_CODE = 1;
constexpr int CW_CNT = 64;
constexpr int CW_BAR = 4096;
#define MEGA_MASK 0x7FFFF
namespace pg8 {
constexpr int BM = 256, BK = 64, HALF = 128, HTB = HALF * BK * 2  , STAGE_BYTES = 8 * HTB, NXCD = 8, WGM = 8;

__host__ __device__ __forceinline__ int lds_byte(int r, int c) { const int st = (r >> 4) * 2 + (c >> 5), rr = r & 15, cc = c & 31, ob = rr * 64 + cc * 2; return st * 1024 + (ob ^ (((ob >> 9) & 1) << 5)); }
__host__ __device__ __forceinline__ void stage_rc(int b, int& R, int& C) { const int st = b / 1024, sb = b % 1024, swz = sb ^ (((sb >> 9) & 1) << 5); R = (st >> 1) * 16 + swz / 64; C = (st & 1) * 32 + (swz % 64) / 2; }
__host__ __device__ __forceinline__ int perm32(int rho) { const int n = rho >> 4, i = rho & 15; return 8 * (i >> 2) + 4 * n + (i & 3); }

struct Unit { const char* A; const char* B; int pm, pn, rows, aux; };


template <class Epi, class Sched, bool ALIGN_EPI, bool GATHER>
__device__ __forceinline__ void gemm_phase(LAS unsigned char* lds, const int K, const Sched& S, const Epi& E) {
    int tid_ = threadIdx.x; asm volatile("" : "+v"(tid_));
    const int tid = tid_, wid = __builtin_amdgcn_readfirstlane(tid >> 6), lane = tid & 63, wr = wid >> 2, wc = wid & 3, fr = lane & 15, fq = lane >> 4;
    const int nt = K / BK;
    unsigned voffA[2][2], voffB[2];
#pragma unroll
    for (int i = 0; i < 2; ++i) { int R, C; stage_rc(tid * 16 + i * 8192, R, C);
        voffA[0][i] = (unsigned)(R * K + C) * 2u; voffA[1][i] = voffA[0][i]; voffB[i] = (unsigned)(R * K + C) * 2u; }
    const size_t kstep = (size_t)(BK * 2);
    const size_t hstep = (size_t)HALF * K * 2;
    const size_t hA = GATHER ? (size_t)0 : hstep;
#define VA1 voffA[GATHER ? 1 : 0]
    const unsigned ldsw = (unsigned)wid * 1024u;
    const int aoff = lds_byte(wr * 64 + fr, fq * 8), boff = lds_byte(wc * 32 + fr, fq * 8);
#define PG8_SA(b, h) (((b) * 2 + (h)) * HTB)
#define PG8_SB(b, h) ((4 + (b) * 2 + (h)) * HTB)
#define PG8_STAGE(bufoff, gbase, voff) do { _Pragma("unroll") for (int _i = 0; _i < 2; ++_i) { unsigned _vo = (voff)[_i]; asm volatile("" : "+v"(_vo));     \
        __builtin_amdgcn_global_load_lds((const unsigned*)((const char*)(gbase) + _vo), (LAS unsigned*)(lds + (bufoff) + ldsw + _i * 8192), 16, 0, 0); } } while (0)
#define PG8_LDA(dst, b, h) do { _Pragma("unroll") for (int m = 0; m < 4; ++m) _Pragma("unroll") for (int k = 0; k < 2; ++k) dst[m][k] = *(const LAS bf16x8*)(lds + PG8_SA(b, h) + aoff + m * 2048 + k * 1024); } while (0)
#define PG8_LDB(dst, b, h) do { _Pragma("unroll") for (int n = 0; n < 2; ++n) _Pragma("unroll") for (int k = 0; k < 2; ++k) dst[n][k] = *(const LAS bf16x8*)(lds + PG8_SB(b, h) + boff + n * 2048 + k * 1024); } while (0)
#define PG8_MMA(ai, bj, At, Bt) do { __builtin_amdgcn_s_setprio(1); _Pragma("unroll") for (int m = 0; m < 4; ++m) _Pragma("unroll") for (int n = 0; n < 2; ++n) _Pragma("unroll") for (int k = 0; k < 2; ++k) \
        acc[ai][bj][m][n] = __builtin_amdgcn_mfma_f32_16x16x32_bf16(Bt[n][k], At[m][k], acc[ai][bj][m][n], 0, 0, 0); __builtin_amdgcn_s_setprio(0); } while (0)
#define PG8_WAIT_V(n) asm volatile("s_waitcnt vmcnt(" #n ")" ::: "memory")
#define PG8_WAIT_L(n) asm volatile("s_waitcnt lgkmcnt(" #n ")" ::: "memory")
#define PG8_BAR __builtin_amdgcn_s_barrier()
#define PG8_SCHED __builtin_amdgcn_sched_barrier(0)
    Unit cur, nxt; int ui = 0;
    if (!S.next(0, cur)) return;
    if constexpr (GATHER) S.voff(0, voffA);
    f32x4 acc[2][2][4][2];
#pragma unroll
    for (int a = 0; a < 2; ++a)
#pragma unroll
        for (int b = 0; b < 2; ++b)
#pragma unroll
            for (int m = 0; m < 4; ++m)
#pragma unroll
                for (int n = 0; n < 2; ++n) acc[a][b][m][n] = (f32x4){0.f, 0.f, 0.f, 0.f};
    bf16x8 At[4][2], B0[2][2], B1[2][2];
    const char* cA = cur.A; const char* cB = cur.B;
    PG8_STAGE(PG8_SB(0, 0), cB, voffB); PG8_STAGE(PG8_SB(0, 1), cB + hstep, voffB); PG8_STAGE(PG8_SA(0, 0), cA, voffA[0]); PG8_STAGE(PG8_SA(0, 1), cA + hA, VA1);
    if (wr == 1) PG8_BAR;
    PG8_WAIT_V(2); PG8_BAR;
    PG8_STAGE(PG8_SB(1, 0), cB + kstep, voffB); PG8_STAGE(PG8_SA(1, 0), cA + kstep, voffA[0]); PG8_STAGE(PG8_SB(1, 1), cB + hstep + kstep, voffB);
    PG8_WAIT_V(6); PG8_BAR;
    for (;;) {
        const bool has_next = S.next(ui + 1, nxt);
        const char* nA = has_next ? nxt.A : cA; const char* nB = has_next ? nxt.B : cB;
        for (int t = 0; t < nt; t += 2) {
            const bool last = (t == nt - 2);
            const char* a1 = cA + (size_t)(t + 1) * kstep;
            const char* a2 = last ? nA : cA + (size_t)(t + 2) * kstep; const char* b2 = last ? nB : cB + (size_t)(t + 2) * kstep;
            const char* a3 = a2 + kstep; const char* b3 = b2 + kstep;
            PG8_LDB(B0, 0, 0); PG8_LDB(B1, 0, 1); PG8_SCHED; PG8_LDA(At, 0, 0); PG8_STAGE(PG8_SA(1, 1), a1 + hA, VA1);
            if constexpr (GATHER) { if (last && has_next) S.voff(ui + 1, voffA); }
            PG8_WAIT_V(8); PG8_WAIT_L(0); PG8_BAR; PG8_MMA(0, 0, At, B0); PG8_MMA(0, 1, At, B1); PG8_BAR; PG8_SCHED;
            PG8_LDA(At, 0, 1); PG8_STAGE(PG8_SB(0, 0), b2, voffB); PG8_STAGE(PG8_SB(0, 1), b2 + hstep, voffB); PG8_STAGE(PG8_SA(0, 0), a2, voffA[0]);
            PG8_WAIT_V(8); PG8_WAIT_L(0); PG8_BAR; PG8_MMA(1, 0, At, B0); PG8_MMA(1, 1, At, B1); PG8_BAR; PG8_SCHED;
            PG8_LDB(B0, 1, 0); PG8_LDB(B1, 1, 1); PG8_SCHED; PG8_LDA(At, 1, 0); PG8_STAGE(PG8_SA(0, 1), a2 + hA, VA1);
            PG8_WAIT_V(8); PG8_WAIT_L(0); PG8_BAR; PG8_MMA(0, 0, At, B0); PG8_MMA(0, 1, At, B1); PG8_BAR; PG8_SCHED;
            PG8_LDA(At, 1, 1); PG8_STAGE(PG8_SB(1, 0), b3, voffB); PG8_STAGE(PG8_SB(1, 1), b3 + hstep, voffB); PG8_STAGE(PG8_SA(1, 0), a3, voffA[0]);
            PG8_WAIT_V(8); PG8_WAIT_L(0); PG8_BAR; PG8_MMA(1, 0, At, B0); PG8_MMA(1, 1, At, B1); PG8_BAR; PG8_SCHED;
        }
        if constexpr (ALIGN_EPI) { if (wr == 0) PG8_BAR; }
        E(acc, cur, wr, wc, fr, fq);
        if (!has_next) break;
#pragma unroll
        for (int a = 0; a < 2; ++a)
#pragma unroll
            for (int b = 0; b < 2; ++b)
#pragma unroll
                for (int m = 0; m < 4; ++m)
#pragma unroll
                    for (int n = 0; n < 2; ++n) acc[a][b][m][n] = (f32x4){0.f, 0.f, 0.f, 0.f};
        cur = nxt; cA = nA; cB = nB; ++ui;
        if constexpr (ALIGN_EPI) { if (wr == 1) PG8_BAR; }
    }
    PG8_WAIT_V(0);
    if constexpr (!ALIGN_EPI) { if (wr == 0) PG8_BAR; }
    PG8_BAR;
#undef VA1
#undef PG8_SA
#undef PG8_SB
#undef PG8_STAGE
#undef PG8_LDA
#undef PG8_LDB
#undef PG8_MMA
#undef PG8_WAIT_V
#undef PG8_WAIT_L
#undef PG8_BAR
#undef PG8_SCHED
}

struct DenseOrder {
    const char* A; const char* B; int nM, nN, nwg, G, c; size_t tstepA, tstepB;
    __device__ void init(const void* A_, const void* B_, int M, int N, int K, int G_, int c_) { A = (const char*)A_; B = (const char*)B_; nM = M / BM; nN = N / BM; nwg = nM * nN; G = G_; c = c_; tstepA = (size_t)BM * K * 2; tstepB = tstepA; }
    __device__ __forceinline__ bool next(int i, Unit& u) const {
        const long L = (long)i * G + c; if (L >= nwg) return false;
        int wgid = (int)L; { const int q = nwg / NXCD, r = nwg % NXCD, xcd = wgid % NXCD, off = wgid / NXCD; wgid = (xcd < r ? xcd * (q + 1) : r * (q + 1) + (xcd - r) * q) + off; }
        const int nig = WGM * nN, gid = wgid / nig, fm = gid * WGM, gsz = (nM - fm) < WGM ? (nM - fm) : WGM;
        u.pm = fm + ((wgid % nig) % gsz); u.pn = (wgid % nig) / gsz; u.A = A + (size_t)u.pm * tstepA; u.B = B + (size_t)u.pn * tstepB; u.rows = BM; u.aux = 0; return true;
    }
    __device__ __forceinline__ void voff(int, unsigned (&)[2][2]) const {}
};
}
namespace pg8 {
__device__ __forceinline__ v4u pack8(const f32x4 a, const f32x4 b) { v4u w; w.x = pk2(a[0], a[1]); w.y = pk2(a[2], a[3]); w.z = pk2(b[0], b[1]); w.w = pk2(b[2], b[3]); return w; }

struct EpiIn0 {
    bf16_t* UB; const float2* rope;
    __device__ __forceinline__ void operator()(const f32x4 (&acc)[2][2][4][2], const Unit& u, int wr, int wc, int fr, int fq) const {
        const int pn = u.pn;
        if (pn == 6 || pn == 7) {
            const float sc = (pn == 7) ? 0.125f : 1.f;
#pragma unroll
            for (int ai = 0; ai < 2; ++ai)
#pragma unroll
                for (int m = 0; m < 4; ++m) {
                    const int row = u.pm * BM + ai * HALF + wr * 64 + m * 16 + fr, s = row & (SEQ - 1);
                    const f32x4* rp = (const f32x4*)(rope + s * 32 + 8 * fq);
                    f32x4 o1[2], o2[2];
#pragma unroll
                    for (int n = 0; n < 2; ++n) {
                        const f32x4 cs0 = rp[2 * n], cs1 = rp[2 * n + 1];
                        const f32x4 x1 = acc[ai][0][m][n], x2 = acc[ai][1][m][n];
                        const f32x4 c = {cs0[0], cs0[2], cs1[0], cs1[2]}, sn = {cs0[1], cs0[3], cs1[1], cs1[3]};
                        o1[n] = (x1 * c - x2 * sn) * sc; o2[n] = (x2 * c + x1 * sn) * sc;
                    }
                    bf16_t* p = UB + (size_t)row * UBW + pn * BM + 64 * wc + 8 * fq;
                    *(v4u*)p = pack8(o1[0], o1[1]); *(v4u*)(p + 32) = pack8(o2[0], o2[1]);
                }
        } else {
            const float sc = (pn < 2) ? SCQ : 1.f;
#pragma unroll
            for (int ai = 0; ai < 2; ++ai)
#pragma unroll
                for (int m = 0; m < 4; ++m) {
                    const int row = u.pm * BM + ai * HALF + wr * 64 + m * 16 + fr;
                    bf16_t* p = UB + (size_t)row * UBW + pn * BM + 32 * wc + 8 * fq;
#pragma unroll
                    for (int bj = 0; bj < 2; ++bj) *(v4u*)(p + bj * HALF) = pack8(acc[ai][bj][m][0] * sc, acc[ai][bj][m][1] * sc);
                }
        }
    }
};

struct EpiIn1 {
    bf16_t* UB; float* LF;
    __device__ __forceinline__ void operator()(const f32x4 (&acc)[2][2][4][2], const Unit& u, int wr, int wc, int fr, int fq) const {
        const int pn = u.pn;
        if (pn == 12) {
            if (wc == 0 && fq < 2) {
#pragma unroll
                for (int ai = 0; ai < 2; ++ai)
#pragma unroll
                    for (int m = 0; m < 4; ++m) {
                        const int row = u.pm * BM + ai * HALF + wr * 64 + m * 16 + fr;
                        float* p = LF + (size_t)row * 16 + 8 * fq;
                        *(f32x4*)p = acc[ai][0][m][0]; *(f32x4*)(p + 4) = acc[ai][0][m][1];
                    }
            }
        } else {
            const float sc = (pn < 4) ? SCQ : 1.f;
#pragma unroll
            for (int ai = 0; ai < 2; ++ai)
#pragma unroll
                for (int m = 0; m < 4; ++m) {
                    const int row = u.pm * BM + ai * HALF + wr * 64 + m * 16 + fr;
                    bf16_t* p = UB + (size_t)row * UBW + pn * BM + 32 * wc + 8 * fq;
#pragma unroll
                    for (int bj = 0; bj < 2; ++bj) *(v4u*)(p + bj * HALF) = pack8(acc[ai][bj][m][0] * sc, acc[ai][bj][m][1] * sc);
                }
        }
    }
};

struct EpiF32 {
    float* O; int ldc;
    __device__ __forceinline__ void operator()(const f32x4 (&acc)[2][2][4][2], const Unit& u, int wr, int wc, int fr, int fq) const {
#pragma unroll
        for (int ai = 0; ai < 2; ++ai)
#pragma unroll
            for (int m = 0; m < 4; ++m) {
                const int row = u.pm * BM + ai * HALF + wr * 64 + m * 16 + fr;
                float* p = O + (size_t)row * ldc + u.pn * BM + 32 * wc + 8 * fq;
#pragma unroll
                for (int bj = 0; bj < 2; ++bj) { *(f32x4*)(p + bj * HALF) = acc[ai][bj][m][0]; *(f32x4*)(p + bj * HALF + 4) = acc[ai][bj][m][1]; }
            }
    }
};
struct EpiBf16 {
    bf16_t* O; int ldc;
    __device__ __forceinline__ void operator()(const f32x4 (&acc)[2][2][4][2], const Unit& u, int wr, int wc, int fr, int fq) const {
#pragma unroll
        for (int ai = 0; ai < 2; ++ai)
#pragma unroll
            for (int m = 0; m < 4; ++m) {
                const int row = u.pm * BM + ai * HALF + wr * 64 + m * 16 + fr;
                bf16_t* p = O + (size_t)row * ldc + u.pn * BM + 32 * wc + 8 * fq;
#pragma unroll
                for (int bj = 0; bj < 2; ++bj) *(v4u*)(p + bj * HALF) = pack8(acc[ai][bj][m][0], acc[ai][bj][m][1]);
            }
    }
};
struct EpiPle {
    float* H2; const bf16_t* PP; bf16_t* XB;
    __device__ __forceinline__ void operator()(const f32x4 (&acc)[2][2][4][2], const Unit& u, int wr, int wc, int fr, int fq) const {
#pragma unroll
        for (int ai = 0; ai < 2; ++ai)
#pragma unroll
            for (int m = 0; m < 4; ++m) {
                const int row = u.pm * BM + ai * HALF + wr * 64 + m * 16 + fr;
                const size_t off = (size_t)row * DM + u.pn * BM + 32 * wc + 8 * fq;
#pragma unroll
                for (int bj = 0; bj < 2; ++bj) {
                    float* hp = H2 + off + bj * HALF;
                    const f32x4 h0 = *(const f32x4*)hp, h1 = *(const f32x4*)(hp + 4);
                    const v4u pw = *(const v4u*)(PP + off + bj * HALF);
                    const f32x4 p0 = {bflo(pw.x), bfhi(pw.x), bflo(pw.y), bfhi(pw.y)}, p1 = {bflo(pw.z), bfhi(pw.z), bflo(pw.w), bfhi(pw.w)};
                    f32x4 o0, o1;
#pragma unroll
                    for (int j = 0; j < 4; ++j) { o0[j] = h0[j] + sigmoid_f(acc[ai][bj][m][0][j]) * p0[j]; o1[j] = h1[j] + sigmoid_f(acc[ai][bj][m][1][j]) * p1[j]; }
                    *(f32x4*)hp = o0; *(f32x4*)(hp + 4) = o1;
                    *(v4u*)(XB + off + bj * HALF) = pack8(o0, o1);
                }
            }
    }
};
}
#define RLX_AGENT __ATOMIC_RELAXED, __HIP_MEMORY_SCOPE_AGENT
#define XB_TMO      128
#define XB_XCNT(j)  (256  + 64 * (j))
#define XB_XSUB(j)  (1280 + 64 * (j))
#define XB_XGEN(j)  (2304 + 64 * (j))
#define XB_TOP      3328
#define XB_TOPGEN   3392
#define XCD_BAR_WORDS 3456
#define XB_SPIN_CAP (1u << 18)

__device__ __forceinline__ unsigned xb_ld(unsigned* p)              { return __hip_atomic_load(p, __ATOMIC_RELAXED, __HIP_MEMORY_SCOPE_AGENT); }
__device__ __forceinline__ unsigned xb_add(unsigned* p, unsigned v) { return __hip_atomic_fetch_add(p, v, __ATOMIC_RELAXED, __HIP_MEMORY_SCOPE_AGENT); }
__device__ __forceinline__ unsigned xb_xcc_id() { return (unsigned)__builtin_amdgcn_s_getreg((3 << 11) | 20) & 0xFu; }
#define XB_SPIN(cond, bar) do { unsigned _sp = 0; while (cond) { __builtin_amdgcn_s_sleep(1); \
    if ((++_sp & 255u) == 0u) { if (xb_ld(&(bar)[XB_TMO])) break; if (_sp > XB_SPIN_CAP) { atomicAdd(&(bar)[XB_TMO], 1u); break; } } } } while (0)

struct XcdBarrier {
    unsigned* bar; unsigned x;
    volatile LAS unsigned* st;
};

__device__ __forceinline__ XcdBarrier xcd_barrier_post(unsigned* bar, volatile LAS unsigned* st) {
    XcdBarrier b; b.bar = bar; b.x = xb_xcc_id(); b.st = st;
    if (threadIdx.x == 0) (void)xb_add(&bar[XB_XCNT(b.x)], 1u);
    return b;
}
__device__ __forceinline__ void xcd_barrier_complete(unsigned* bar, unsigned x, unsigned& nloc, unsigned& nx) {
    const unsigned G = gridDim.x * gridDim.y * gridDim.z;
    unsigned sum, cnt, mine, sp = 0u;
    for (;;) {
        sum = 0u; cnt = 0u; mine = 0u;
#pragma unroll
        for (unsigned j = 0; j < 16; ++j) { const unsigned c = xb_ld(&bar[XB_XCNT(j)]); sum += c; cnt += (c > 0u) ? 1u : 0u; mine = (j == x) ? c : mine; }
        if (sum == G) break;
        __builtin_amdgcn_s_sleep(1);
        if ((++sp & 255u) == 0u) { if (xb_ld(&bar[XB_TMO])) break; if (sp > XB_SPIN_CAP) { atomicAdd(&bar[XB_TMO], 1u); break; } }
    }
    nloc = mine > 0u ? mine : 1u; nx = cnt > 0u ? cnt : 1u;
}

__device__ __forceinline__ void xcd_barrier(const XcdBarrier& b) {
    asm volatile("s_waitcnt vmcnt(0)" ::: "memory");
    __syncthreads();
    if (threadIdx.x == 0) {
        unsigned* bar = b.bar;
        __builtin_amdgcn_s_waitcnt(0);
        unsigned nloc = b.st[0], nx = b.st[1];
        if (nloc == 0u) { xcd_barrier_complete(bar, b.x, nloc, nx); b.st[0] = nloc; b.st[1] = nx; }
        const unsigned old = xb_add(&bar[XB_XSUB(b.x)], 1u);
        const unsigned gen = old / nloc;
        if (old + 1u == (gen + 1u) * nloc) {
            __builtin_amdgcn_fence(__ATOMIC_RELEASE, "agent");
            asm volatile("s_waitcnt vmcnt(0)" ::: "memory");
            const unsigned og = xb_add(&bar[XB_TOP], 1u);
            const unsigned tg = og / nx;
            if (og + 1u == (tg + 1u) * nx) xb_add(&bar[XB_TOPGEN], 1u);
            else XB_SPIN(xb_ld(&bar[XB_TOPGEN]) == tg, bar);
            __builtin_amdgcn_fence(__ATOMIC_ACQUIRE, "agent");
            xb_add(&bar[XB_XGEN(b.x)], 1u);
            asm volatile("s_waitcnt vmcnt(0)" ::: "memory");
        } else {
            XB_SPIN(xb_ld(&bar[XB_XGEN(b.x)]) == gen, bar);
            __builtin_amdgcn_fence(__ATOMIC_ACQUIRE, "agent");
            asm volatile("s_waitcnt vmcnt(0)" ::: "memory");
        }
    }
    __syncthreads();
}

constexpr int NWAVES = 8;
constexpr int RING_OFF = 0, RING_BYTES = 131072;
constexpr int LDSCTL_OFF = RING_BYTES;
constexpr int MISC_OFF = LDSCTL_OFF + 320;
constexpr int MOE_TAB_OFF = LDSCTL_OFF + 1024;
constexpr int VOFF_OFF = MOE_TAB_OFF + 512;
constexpr int LDS_BYTES = 147456;
static_assert(VOFF_OFF + 3 * 4096 <= LDS_BYTES, "LDS map");

struct Args {
    const float* in[21]; float* out; unsigned char* ws; int ph_lo, ph_hi, li, pad;
};

struct Frame {
    LAS unsigned char* lds; volatile LAS unsigned* MISC; unsigned* ctl; unsigned char* ws;
    int tid, lane, wave, vcu, G;
};

__device__ __forceinline__ void p0_item(const float* __restrict__ src, int ld, int col0, int nvalid, int k0, bf16_t* __restrict__ dst, int Kd, LAS float* scr, int lane) {
    const int c = lane & 31;
#pragma unroll 8
    for (int i = 0; i < 32; ++i) { const int kk = 2 * i + (lane >> 5); scr[kk * 33 + c] = (c < nvalid) ? src[(size_t)(k0 + kk) * ld + col0 + c] : 0.f; }
    asm volatile("s_waitcnt lgkmcnt(0)" ::: "memory");
    const int ch = lane & 7;
#pragma unroll
    for (int j = 0; j < 4; ++j) { const int rho = (lane >> 3) + 8 * j; const LAS float* s = scr + (8 * ch) * 33 + pg8::perm32(rho);
        v4u o; o.x = pk2(s[0 * 33], s[1 * 33]); o.y = pk2(s[2 * 33], s[3 * 33]); o.z = pk2(s[4 * 33], s[5 * 33]); o.w = pk2(s[6 * 33], s[7 * 33]);
        *(v4u*)(dst + (size_t)rho * Kd + k0 + 8 * ch) = o; }
    asm volatile("s_waitcnt lgkmcnt(0)" ::: "memory");
}
__device__ __forceinline__ void p0_plain(const float* W, int K, int N, bf16_t* WT, LAS float* scr, int r, int lane) {
    const int ng = N / 32, kb = r / ng, g = r % ng;
    p0_item(W, N, 32 * g, 32, 64 * kb, WT + (size_t)(32 * g) * K, K, scr, lane);
}

__device__ __forceinline__ void p0_prologue(Frame& F, const Args& a) {
    LAS float* scr = (LAS float*)(F.lds + RING_OFF + F.wave * 16384);
    const int gw = F.vcu * NWAVES + F.wave, NGW = F.G * NWAVES, lane = F.lane;
    unsigned char* ws = F.ws;
    const float* even_w_in = a.in[4]; const float* even_w_out = a.in[5]; const float* odd_w_in = a.in[9]; const float* odd_w_out = a.in[11];
    const float* moe_g = a.in[16]; const float* moe_u = a.in[17]; const float* moe_d = a.in[18]; const float* ple_proj = a.in[19]; const float* ple_gate = a.in[20];
    constexpr int I_IN0 = 16 * 96, I_OUT = 16 * 32, I_IN1 = 16 * 104, I_PLEG = 16 * 32, I_PLEP = 4 * 32, I_GU = 16 * 32, I_DN = 8 * 32;
    constexpr int I_SMALL = I_IN0 + I_OUT + I_IN1 + I_OUT + 2 * I_PLEG + 2 * I_PLEP, I_MOE = 32 * (I_GU + I_DN), NITEMS = I_SMALL + I_MOE;
    for (int it = gw; it < NITEMS; it += NGW) {
        int r = it;
        if (r < I_IN0) {
            const int kb = r / 96, g = r % 96, pn = g / 8;
            int col0 = 32 * g;
            if (pn == 6 || pn == 7) { const int gl = g % 8, bj = gl / 4, wc = gl % 4; col0 = pn * 256 + 64 * wc + 32 * bj; }
            p0_item(even_w_in, EVEN_IN, col0, 32, 64 * kb, (bf16_t*)(ws + W_IN0) + (size_t)(32 * g) * DM, DM, scr, lane); continue; }
        r -= I_IN0;
        if (r < I_OUT) { p0_plain(even_w_out, DM, DM, (bf16_t*)(ws + W_OUT0), scr, r, lane); continue; } r -= I_OUT;
        if (r < I_IN1) {
            const int kb = r / 104, g = r % 104; int nv = ODD_IN - 32 * g; nv = nv < 0 ? 0 : (nv > 32 ? 32 : nv);
            p0_item(odd_w_in, ODD_IN, 32 * g, nv, 64 * kb, (bf16_t*)(ws + W_IN1) + (size_t)(32 * g) * DM, DM, scr, lane); continue; }
        r -= I_IN1;
        if (r < I_OUT) { p0_plain(odd_w_out, DM, DM, (bf16_t*)(ws + W_OUT1), scr, r, lane); continue; } r -= I_OUT;
        if (r < 2 * I_PLEG) { const int l = r / I_PLEG; p0_plain(ple_gate + (size_t)l * DM * DM, DM, DM, (bf16_t*)(ws + W_PLEG) + (size_t)l * DM * DM, scr, r % I_PLEG, lane); continue; } r -= 2 * I_PLEG;
        if (r < 2 * I_PLEP) { const int l = r / I_PLEP; p0_plain(ple_proj + (size_t)l * 256 * DM, 256, DM, (bf16_t*)(ws + W_PLEP) + (size_t)l * DM * 256, scr, r % I_PLEP, lane); continue; } r -= 2 * I_PLEP;
        {
            const int le = r / (I_GU + I_DN); int q = r % (I_GU + I_DN);
            if (q < I_GU) {
                const int kb = q / 32, g = q % 32, pn = g / 8, gl = g % 8, bj = gl / 4, wc = gl % 4;
                const float* src = (bj == 0 ? moe_g : moe_u) + (size_t)le * DM * 512;
                p0_item(src, 512, 128 * pn + 32 * wc, 32, 64 * kb, (bf16_t*)(ws + W_GU) + (size_t)le * 1024 * 1024 + (size_t)(32 * g) * DM, DM, scr, lane);
            } else { q -= I_GU; p0_plain(moe_d + (size_t)le * 512 * DM, 512, DM, (bf16_t*)(ws + W_DN) + (size_t)le * DM * 512, scr, q, lane); }
        }
    }
    { const float* x = a.in[0]; bf16_t* xb = (bf16_t*)(ws + WS_D);
      for (int m = gw; m < T; m += NGW) { const f32x4* xr = (const f32x4*)(x + (size_t)m * DM) + lane; v2u* o = (v2u*)(xb + (size_t)m * DM) + lane;
#pragma unroll
          for (int j = 0; j < 4; ++j) { const f32x4 v = xr[64 * j]; v2u w; w.x = pk2(v[0], v[1]); w.y = pk2(v[2], v[3]); o[64 * j] = w; } } }
    { const int gt = (F.vcu * NWAVES + F.wave) * 64 + lane, NT = F.G * NWAVES * 64;
      float2* rope = (float2*)(ws + WS_ROPE); float* bt = (float*)(ws + WS_BT); float* lamp = (float*)(ws + WS_LAM);
      for (int g = gt; g < SEQ * 32; g += NT) { const int s = g >> 5, i = g & 31;
          const float inv = (float)pow(10000.0, -(double)i / 32.0); const float ang = (float)s * inv;
          rope[g] = make_float2((float)cos((double)ang), (float)sin((double)ang)); }
      if (gt < 512) { const int h = gt >> 7, dist = gt & 127; int bucket = dist;
          if (dist >= 16) { const int large = 16 + (int)(logf((float)dist / 16.0f) / logf(8.0f) * 16.0f); bucket = large < 31 ? large : 31; }
          bt[gt] = a.in[2][bucket * 4 + h] * LOG2E; }
      if (gt == 0) { const float* lp = a.in[6]; float s01 = 0.f, s23 = 0.f;
          for (int i = 0; i < 64; ++i) { s01 += lp[i] * lp[64 + i]; s23 += lp[128 + i] * lp[192 + i]; }
          lamp[0] = expf(s01) - expf(s23) + 0.2f; } }
}
constexpr int ROWS_PER_WG = 64;
struct TokEP { int e0, p0, e1, p1; };

__device__ __forceinline__ void xreduce32(float (&v)[32], int lane) {
#pragma unroll
    for (int s = 0; s < 5; ++s) {
        const int n = 32 >> s, hn = n >> 1; const bool up = (lane >> s) & 1;
#pragma unroll
        for (int i = 0; i < hn; ++i) { const float a = v[i], b = v[i + hn]; const float send = up ? a : b, keep = up ? b : a; v[i] = keep + __shfl_xor(send, 1 << s); }
    }
    v[0] += __shfl_xor(v[0], 32);
}

__device__ __forceinline__ void ph_ln1_route(Frame& F, const float* xin, const float* __restrict__ MIX, const float* __restrict__ lng, const float* __restrict__ lnb, const float* __restrict__ router_w,
                                             float* H, bf16_t* __restrict__ HB, unsigned* cnt  , TokEP* __restrict__ tok_ep, float2* __restrict__ tok_g, int* __restrict__ list, float* __restrict__ listg) {
    LAS float* rwT = (LAS float*)(F.lds + RING_OFF);
    LAS float* lg = (LAS float*)(F.lds + RING_OFF + 65536) + F.wave * 64;
    LAS int* lcnt = (LAS int*)(F.lds + RING_OFF + 65536 + 2048);
    LAS int* rec = (LAS int*)(F.lds + RING_OFF + 65536 + 2048 + 128);
    int tid_ = threadIdx.x; asm volatile("" : "+v"(tid_));
    const int tid = tid_, lane = tid & 63, wave = F.wave;
    for (int i = tid; i < 16 * DM; i += NWAVES * 64) { const int c = i >> 4, e = i & 15; rwT[e * DM + c] = router_w[i]; }
    if (tid < 32) lcnt[tid] = 0;
    __syncthreads();
    const int row0 = (int)blockIdx.x * ROWS_PER_WG + wave * 8;
    f32x4 gv[4], bv[4];
#pragma unroll
    for (int j = 0; j < 4; ++j) { gv[j] = *((const f32x4*)lng + lane + 64 * j); bv[j] = *((const f32x4*)lnb + lane + 64 * j); }
#pragma nounroll
    for (int batch = 0; batch < 4; ++batch) {
        f32x4 h[2][4];
#pragma unroll
        for (int r = 0; r < 2; ++r) {
            const size_t ro = (size_t)(row0 + batch * 2 + r) * DM;
            float s = 0.f;
#pragma unroll
            for (int j = 0; j < 4; ++j) { const f32x4 xv = *((const f32x4*)(xin + ro) + lane + 64 * j), mv = *((const f32x4*)(MIX + ro) + lane + 64 * j); h[r][j] = xv * ALPHA + mv; s += (h[r][j][0] + h[r][j][1]) + (h[r][j][2] + h[r][j][3]); }
            const float mu = wave_sum(s) * (1.f / DM); float q = 0.f;
#pragma unroll
            for (int j = 0; j < 4; ++j) { h[r][j] = h[r][j] - mu; q += (h[r][j][0] * h[r][j][0] + h[r][j][1] * h[r][j][1]) + (h[r][j][2] * h[r][j][2] + h[r][j][3] * h[r][j][3]); }
            const float rs = rsqrtf(wave_sum(q) * (1.f / DM) + LN_EPS);
#pragma unroll
            for (int j = 0; j < 4; ++j) { h[r][j] = h[r][j] * rs * gv[j] + bv[j];
                *((f32x4*)(H + ro) + lane + 64 * j) = h[r][j];
                v2u w; w.x = pk2(h[r][j][0], h[r][j][1]); w.y = pk2(h[r][j][2], h[r][j][3]); *((v2u*)(HB + ro) + lane + 64 * j) = w; }
        }
        float acc[32];
#pragma unroll
        for (int i = 0; i < 32; ++i) acc[i] = 0.f;
#pragma unroll
        for (int e = 0; e < 16; ++e) {
#pragma unroll
            for (int j = 0; j < 4; ++j) { const f32x4 w = *((const LAS f32x4*)(rwT + e * DM) + lane + 64 * j);
#pragma unroll
                for (int r = 0; r < 2; ++r) acc[r * 16 + e] += (h[r][j][0] * w[0] + h[r][j][1] * w[1]) + (h[r][j][2] * w[2] + h[r][j][3] * w[3]); }
            if ((e & 3) == 3) __builtin_amdgcn_sched_barrier(0);
        }
        xreduce32(acc, lane);
        if (lane < 32) { const int idx = (int)(__builtin_bitreverse32((unsigned)lane) >> 27); lg[idx] = acc[0]; }
        asm volatile("s_waitcnt lgkmcnt(0)" ::: "memory");
        if (lane < 2) {
            float p[16]; float mx = -INFINITY;
#pragma unroll
            for (int e = 0; e < 16; ++e) { p[e] = lg[lane * 16 + e]; mx = fmaxf(mx, p[e]); }
            float sum = 0.f;
#pragma unroll
            for (int e = 0; e < 16; ++e) { p[e] = expf(p[e] - mx); sum += p[e]; }
#pragma unroll
            for (int e = 0; e < 16; ++e) p[e] = p[e] / sum;
            int be0 = 0, be1 = 1; float bs = -1.f, bv0 = 0.f, bv1 = 0.f;
#pragma unroll
            for (int g = 0; g < 4; ++g) {
                int i0 = 0; float v0 = p[4 * g];
#pragma unroll
                for (int j = 1; j < 4; ++j) if (p[4 * g + j] > v0) { v0 = p[4 * g + j]; i0 = j; }
                int i1 = -1; float v1 = -1.f;
#pragma unroll
                for (int j = 0; j < 4; ++j) if (j != i0 && p[4 * g + j] > v1) { v1 = p[4 * g + j]; i1 = j; }
                const float sc = v0 + v1;
                if (sc > bs) { bs = sc; be0 = 4 * g + i0; be1 = 4 * g + i1; bv0 = v0; bv1 = v1; }
            }
            const float g0 = bv0 / (bv0 + bv1), g1 = bv1 / (bv0 + bv1);
            const int lp0 = __hip_atomic_fetch_add(lcnt + be0, 1, __ATOMIC_RELAXED, __HIP_MEMORY_SCOPE_WORKGROUP);
            const int lp1 = __hip_atomic_fetch_add(lcnt + be1, 1, __ATOMIC_RELAXED, __HIP_MEMORY_SCOPE_WORKGROUP);
            LAS int* rc = rec + (wave * 8 + batch * 2 + lane) * 6;
            rc[0] = be0; rc[1] = lp0; rc[2] = be1; rc[3] = lp1; rc[4] = __float_as_int(g0); rc[5] = __float_as_int(g1);
        }
    }
    __syncthreads();
    if (tid < 16) { const int c = lcnt[tid]; lcnt[16 + tid] = c > 0 ? (int)__hip_atomic_fetch_add(cnt + 64 * tid, (unsigned)c, __ATOMIC_RELAXED, __HIP_MEMORY_SCOPE_AGENT) : 0; }
    __syncthreads();
    if (tid < ROWS_PER_WG) {
        const LAS int* rc = rec + tid * 6; const int token = (int)blockIdx.x * ROWS_PER_WG + tid;
        const int e0 = rc[0], e1 = rc[2], p0 = lcnt[16 + e0] + rc[1], p1 = lcnt[16 + e1] + rc[3];
        tok_ep[token] = TokEP{e0, p0, e1, p1}; tok_g[token] = make_float2(__int_as_float(rc[4]), __int_as_float(rc[5]));
        list[e0 * T + p0] = token; list[e1 * T + p1] = token; listg[e0 * T + p0] = __int_as_float(rc[4]); listg[e1 * T + p1] = __int_as_float(rc[5]);
    }
    __syncthreads();
}

__device__ __forceinline__ void moe_tables(Frame& F, const unsigned* cnt) {
    LAS int* tab = (LAS int*)(F.lds + MOE_TAB_OFF);
    if (threadIdx.x == 0) { int off = 0, tb = 0;
        for (int e = 0; e < 16; ++e) { const int c = (int)__hip_atomic_load(cnt + 64 * e, __ATOMIC_RELAXED, __HIP_MEMORY_SCOPE_AGENT); tab[e] = c; tab[16 + e] = off; tab[33 + e] = tb; off += c; tb += (c + 255) >> 8; }
        tab[32] = off; tab[49] = tb; }
    __syncthreads();
}

struct MoeOrder {
    const LAS int* tab; LAS unsigned short* vo; const char* Abase; const char* Bbase; size_t estride, nstride; int G, vcu, arow  ;
    __device__ __forceinline__ bool next(int i, pg8::Unit& u) const {
        const int L = i * G + vcu, total = __builtin_amdgcn_readfirstlane(tab[49]) * 4; if (L >= total) return false;
        const int mt = L >> 2, pn = L & 3; int e = 0;
#pragma unroll
        for (int k = 1; k < 16; ++k) e = (tab[33 + k] <= mt) ? k : e;
        e = __builtin_amdgcn_readfirstlane(e);
        const int m = __builtin_amdgcn_readfirstlane(mt - tab[33 + e]), rows = __builtin_amdgcn_readfirstlane(tab[e] - 256 * m), slot0 = __builtin_amdgcn_readfirstlane(tab[16 + e] + 256 * m);
        u.pn = pn; u.pm = e * T + 256 * m; u.aux = slot0; u.rows = rows < 256 ? rows : 256;
        u.A = Abase + (size_t)slot0 * arow; u.B = Bbase + (size_t)e * estride + (size_t)pn * nstride; return true;
    }
    __device__ __forceinline__ void voff(int i, unsigned (&v)[2][2]) const {
        int tid = threadIdx.x; asm volatile("" : "+v"(tid));
#pragma unroll
        for (int h = 0; h < 2; ++h)
#pragma unroll
            for (int p = 0; p < 2; ++p) { int R, C; pg8::stage_rc(tid * 16 + p * 8192, R, C); v[h][p] = (unsigned)vo[((i * 2 + h) * 2 + p) * 512 + tid] * (unsigned)(DM * 2) + (unsigned)(C * 2); }
    }
    __device__ __forceinline__ void build(const int* __restrict__ list) const {
        int tid = threadIdx.x; asm volatile("" : "+v"(tid)); pg8::Unit u;
        for (int i = 0; i < 3; ++i) { if (!next(i, u)) break;
#pragma unroll
            for (int h = 0; h < 2; ++h)
#pragma unroll
                for (int p = 0; p < 2; ++p) { int R, C; pg8::stage_rc(tid * 16 + p * 8192, R, C); const int r = h * 128 + R;
                    vo[((i * 2 + h) * 2 + p) * 512 + tid] = (unsigned short)list[u.pm + (r < u.rows ? r : 0)]; } }
        __syncthreads();
    }
};

namespace pg8 {
struct EpiGateUp {
    bf16_t* ACT;
    __device__ __forceinline__ void operator()(const f32x4 (&acc)[2][2][4][2], const Unit& u, int wr, int wc, int fr, int fq) const {
#pragma unroll
        for (int ai = 0; ai < 2; ++ai)
#pragma unroll
            for (int m = 0; m < 4; ++m) {
                const int r = ai * HALF + wr * 64 + m * 16 + fr;
                if (r < u.rows) {
                    f32x4 o[2];
#pragma unroll
                    for (int n = 0; n < 2; ++n)
#pragma unroll
                        for (int j = 0; j < 4; ++j) o[n][j] = silu_f(acc[ai][0][m][n][j]) * acc[ai][1][m][n][j];
                    *(v4u*)(ACT + (size_t)(u.aux + r) * 512 + u.pn * 128 + 32 * wc + 8 * fq) = pack8(o[0], o[1]);
                }
            }
    }
};
struct EpiDown {
    bf16_t* YS; const float* listg;
    __device__ __forceinline__ void operator()(const f32x4 (&acc)[2][2][4][2], const Unit& u, int wr, int wc, int fr, int fq) const {
#pragma unroll
        for (int ai = 0; ai < 2; ++ai)
#pragma unroll
            for (int m = 0; m < 4; ++m) {
                const int r = ai * HALF + wr * 64 + m * 16 + fr;
                if (r < u.rows) {
                    const float g = listg[u.pm + r];
                    bf16_t* p = YS + (size_t)(u.aux + r) * DM + u.pn * BM + 32 * wc + 8 * fq;
#pragma unroll
                    for (int bj = 0; bj < 2; ++bj) *(v4u*)(p + bj * HALF) = pack8(acc[ai][bj][m][0] * g, acc[ai][bj][m][1] * g);
                }
            }
    }
};
}

__device__ __forceinline__ void ph_ln2(Frame& F, float* H, const bf16_t* __restrict__ YS, const TokEP* __restrict__ tok_ep, const float* __restrict__ lng, const float* __restrict__ lnb, bf16_t* __restrict__ H2B) {
    const LAS int* tab = (const LAS int*)(F.lds + MOE_TAB_OFF);
    int tid_ = threadIdx.x; asm volatile("" : "+v"(tid_));
    const int lane = tid_ & 63, row0 = (int)blockIdx.x * ROWS_PER_WG + F.wave * 8;
    f32x4 gv[4], bv[4];
#pragma unroll
    for (int j = 0; j < 4; ++j) { gv[j] = *((const f32x4*)lng + lane + 64 * j); bv[j] = *((const f32x4*)lnb + lane + 64 * j); }
#pragma nounroll
    for (int r = 0; r < 8; ++r) {
        const int row = row0 + r; const size_t ro = (size_t)row * DM;
        const TokEP ep = tok_ep[row];
        const size_t s0 = (size_t)(tab[16 + ep.e0] + ep.p0) * DM, s1 = (size_t)(tab[16 + ep.e1] + ep.p1) * DM;
        f32x4 v[4]; float s = 0.f;
#pragma unroll
        for (int j = 0; j < 4; ++j) { const f32x4 hv = *((const f32x4*)(H + ro) + lane + 64 * j); const v2u a = *((const v2u*)(YS + s0) + lane + 64 * j), b = *((const v2u*)(YS + s1) + lane + 64 * j);
            const f32x4 ya = {bflo(a.x), bfhi(a.x), bflo(a.y), bfhi(a.y)}, yb = {bflo(b.x), bfhi(b.x), bflo(b.y), bfhi(b.y)};
            v[j] = hv * ALPHA + (ya + yb); s += (v[j][0] + v[j][1]) + (v[j][2] + v[j][3]); }
        const float mu = wave_sum(s) * (1.f / DM); float q = 0.f;
#pragma unroll
        for (int j = 0; j < 4; ++j) { v[j] = v[j] - mu; q += (v[j][0] * v[j][0] + v[j][1] * v[j][1]) + (v[j][2] * v[j][2] + v[j][3] * v[j][3]); }
        const float rs = rsqrtf(wave_sum(q) * (1.f / DM) + LN_EPS);
#pragma unroll
        for (int j = 0; j < 4; ++j) { const f32x4 o = v[j] * rs * gv[j] + bv[j]; *((f32x4*)(H + ro) + lane + 64 * j) = o;
            v2u w; w.x = pk2(o[0], o[1]); w.y = pk2(o[2], o[3]); *((v2u*)(H2B + ro) + lane + 64 * j) = w; }
    }
}
namespace att {
__device__ __forceinline__ int crow(int r, int hi) { return (r & 3) + 8 * (r >> 2) + 4 * hi; }
typedef short v4i16_t __attribute__((ext_vector_type(4)));
__device__ __forceinline__ s16x4 vtr(const LAS unsigned char* p) { return __builtin_bit_cast(s16x4, __builtin_amdgcn_ds_read_tr16_b64_v4i16((LAS v4i16_t*)p)); }
__device__ __forceinline__ unsigned cvtpk(float lo, float hi) { typedef float f2 __attribute__((ext_vector_type(2))); typedef __bf16 b2 __attribute__((ext_vector_type(2))); f2 v = {lo, hi}; b2 b = __builtin_convertvector(v, b2); return __builtin_bit_cast(unsigned, b); }

template <int MODE>
__device__ __forceinline__ void attn_unit(LAS unsigned char* lds, const bf16_t* __restrict__ UB, bf16_t* __restrict__ Y, int b, int h, int qb,
                                          const float* __restrict__ btab  , float lam, const float* __restrict__ diff_g, const float* __restrict__ cum  ) {
    constexpr int QB = MODE == 0 ? 128 : 256, KW = MODE == 0 ? 128 : 64, DV = MODE == 0 ? 128 : 64, NDB = DV / 32;
    constexpr int KSTR = KW * 2 + 16, VSTR = DV * 2 + 16;
    constexpr int KOFF = 0, VOFF = 2 * 64 * KSTR, CBOFF = VOFF + 2 * 64 * VSTR, BTOFF = CBOFF + 2 * 256, WSOFF = BTOFF + 512;
    constexpr int NCK = KW / 64, NCV = DV / 64;
    int tid_ = threadIdx.x; asm volatile("" : "+v"(tid_));
    const int tid = tid_, lane = tid & 63, wave = __builtin_amdgcn_readfirstlane(tid >> 6), r32 = lane & 31, hi = lane >> 5;
    const int comp = MODE == 0 ? (wave >> 2) : 0, qw = MODE == 0 ? (wave & 3) : wave;
    const int q0 = qb * QB, q0w = q0 + 32 * qw;
    const bf16_t* Ub = UB + (size_t)b * SEQ * UBW;
    const int kcol = MODE == 0 ? 512 + h * 128 : 1024 + h * 64, vcol = MODE == 0 ? 1024 + h * 128 : 2048 + h * 64;
    LAS float* wsf = (LAS float*)(lds + WSOFF) + wave * 64;
    LAS float* BT = (LAS float*)(lds + BTOFF);
    const float* cb_g = MODE == 1 ? cum + (size_t)(b * 16 + h) * SEQ : nullptr;
    const float cref = MODE == 1 ? cb_g[q0] : 0.f;
    if (MODE == 0 && tid < 128) BT[tid] = btab[h * 128 + tid];
    bf16x8 qf[4];
    { const bf16_t* qp = Ub + (size_t)(q0w + r32) * UBW + (MODE == 0 ? h * 128 + comp * 64 : h * 64) + 8 * hi;
#pragma unroll
      for (int ks = 0; ks < 4; ++ks) qf[ks] = *(const bf16x8*)(qp + 16 * ks); }
    float m = -1e30f, l = 0.f;
    f32x16 o[NDB];
#pragma unroll
    for (int d = 0; d < NDB; ++d)
#pragma unroll
        for (int r = 0; r < 16; ++r) o[d][r] = 0.f;
    const int NT = (q0 + QB) / 64;
    v4u kreg[NCK], vreg[NCV];
#define ATT_GLOAD(t) do { \
        _Pragma("unroll") for (int c = 0; c < NCK; ++c) { const int ci = tid + 512 * c, row = ci / (KW / 8), ch = ci % (KW / 8); kreg[c] = *(const v4u*)(Ub + (size_t)((t) * 64 + row) * UBW + kcol + ch * 8); } \
        _Pragma("unroll") for (int c = 0; c < NCV; ++c) { const int ci = tid + 512 * c, row = ci / (DV / 8), ch = ci % (DV / 8); vreg[c] = *(const v4u*)(Ub + (size_t)((t) * 64 + row) * UBW + vcol + ch * 8); } } while (0)
#define ATT_LSTORE(t) do { const int buf_ = (t) & 1; \
        _Pragma("unroll") for (int c = 0; c < NCK; ++c) { const int ci = tid + 512 * c, row = ci / (KW / 8), ch = ci % (KW / 8); *(LAS v4u*)(lds + KOFF + buf_ * 64 * KSTR + row * KSTR + ch * 16) = kreg[c]; } \
        _Pragma("unroll") for (int c = 0; c < NCV; ++c) { const int ci = tid + 512 * c, row = ci / (DV / 8), ch = ci % (DV / 8); *(LAS v4u*)(lds + VOFF + buf_ * 64 * VSTR + row * VSTR + ch * 16) = vreg[c]; } \
        if (MODE == 1 && tid < 64) ((LAS float*)(lds + CBOFF))[buf_ * 64 + tid] = cref - cb_g[(t) * 64 + tid]; } while (0)
    ATT_GLOAD(0); ATT_LSTORE(0);
    __syncthreads();
    const int i16 = lane & 15, g1 = (lane >> 4) & 1;
    for (int t = 0; t < NT; ++t) {
        const int buf = t & 1, k0 = t * 64;
        if (t + 1 < NT) ATT_GLOAD(t + 1);
        if (k0 <= q0w + 31) {
            const LAS unsigned char* Kb = lds + KOFF + buf * 64 * KSTR + r32 * KSTR + (comp * 64 + 8 * hi) * 2;
            const LAS unsigned char* Vb = lds + VOFF + buf * 64 * VSTR + (4 * hi + (i16 >> 2)) * VSTR + (16 * g1 + 4 * (i16 & 3)) * 2;
            f32x16 p0, p1;
            if (MODE == 1) {
                const LAS float* cbp = (const LAS float*)(lds + CBOFF) + buf * 64 + 4 * hi;
#pragma unroll
                for (int g = 0; g < 4; ++g) { const f32x4 c0 = *(const LAS f32x4*)(cbp + 8 * g), c1 = *(const LAS f32x4*)(cbp + 32 + 8 * g);
#pragma unroll
                    for (int j = 0; j < 4; ++j) { p0[4 * g + j] = c0[j]; p1[4 * g + j] = c1[j]; } }
            } else {
                const float c31 = (q0w - (k0 + 63) >= 113) ? BT[127] : 0.f;
#pragma unroll
                for (int r = 0; r < 16; ++r) { p0[r] = c31; p1[r] = c31; }
            }
#pragma unroll
            for (int ks = 0; ks < 4; ++ks) {
                const bf16x8 ka = *(const LAS bf16x8*)(Kb + ks * 32), kb2 = *(const LAS bf16x8*)(Kb + 32 * KSTR + ks * 32);
                p0 = __builtin_amdgcn_mfma_f32_32x32x16_bf16(ka, qf[ks], p0, 0, 0, 0);
                p1 = __builtin_amdgcn_mfma_f32_32x32x16_bf16(kb2, qf[ks], p1, 0, 0, 0);
            }
            const int qa = q0w + r32;
            if (MODE == 0) {
                if (q0w - (k0 + 63) < 113) {
#pragma unroll
                    for (int r = 0; r < 16; ++r) { const int d0 = qa - (k0 + crow(r, hi)), d1 = d0 - 32;
                        p0[r] = d0 < 0 ? -INFINITY : p0[r] + BT[d0 > 127 ? 127 : d0];
                        p1[r] = d1 < 0 ? -INFINITY : p1[r] + BT[d1 > 127 ? 127 : (d1 < 0 ? 0 : d1)]; }
                }
            } else {
                if (k0 + 63 > q0w) {
#pragma unroll
                    for (int r = 0; r < 16; ++r) { const int kv = k0 + crow(r, hi); if (kv > qa) p0[r] = -INFINITY; if (kv + 32 > qa) p1[r] = -INFINITY; }
                }
            }
            float rm = fmaxf(p0[0], p1[0]);
#pragma unroll
            for (int r = 1; r < 16; ++r) rm = fmaxf(rm, fmaxf(p0[r], p1[r]));
            rm = fmaxf(rm, __shfl_xor(rm, 32));
            const float mn = fmaxf(m, rm), alpha = __builtin_amdgcn_exp2f(m - mn);
            m = mn;
            float ps = 0.f;
#pragma unroll
            for (int r = 0; r < 16; ++r) { p0[r] = __builtin_amdgcn_exp2f(p0[r] - mn); p1[r] = __builtin_amdgcn_exp2f(p1[r] - mn); ps += p0[r] + p1[r]; }
            l = l * alpha + ps;
            if (hi == 0) wsf[r32] = alpha;
            bf16x8 pa[4];
#pragma unroll
            for (int s = 0; s < 2; ++s) {
                v4u w0, w1;
                w0.x = cvtpk(p0[8 * s + 0], p0[8 * s + 1]); w0.y = cvtpk(p0[8 * s + 2], p0[8 * s + 3]); w0.z = cvtpk(p0[8 * s + 4], p0[8 * s + 5]); w0.w = cvtpk(p0[8 * s + 6], p0[8 * s + 7]);
                w1.x = cvtpk(p1[8 * s + 0], p1[8 * s + 1]); w1.y = cvtpk(p1[8 * s + 2], p1[8 * s + 3]); w1.z = cvtpk(p1[8 * s + 4], p1[8 * s + 5]); w1.w = cvtpk(p1[8 * s + 6], p1[8 * s + 7]);
                pa[s] = __builtin_bit_cast(bf16x8, w0); pa[2 + s] = __builtin_bit_cast(bf16x8, w1);
            }
            float al[16];
#pragma unroll
            for (int r = 0; r < 16; ++r) al[r] = wsf[crow(r, hi)];
#pragma unroll
            for (int d = 0; d < NDB; ++d)
#pragma unroll
                for (int r = 0; r < 16; ++r) o[d][r] *= al[r];
#pragma unroll
            for (int d = 0; d < NDB; ++d)
#pragma unroll
                for (int s = 0; s < 4; ++s) {
                    const s16x4 lo = vtr(Vb + (16 * s) * VSTR + d * 64), hh = vtr(Vb + (16 * s + 8) * VSTR + d * 64);
                    const bf16x8 vf = {lo[0], lo[1], lo[2], lo[3], hh[0], hh[1], hh[2], hh[3]};
                    o[d] = __builtin_amdgcn_mfma_f32_32x32x16_bf16(pa[s], vf, o[d], 0, 0, 0);
                }
        }
        if (t + 1 < NT) ATT_LSTORE(t + 1);
        __syncthreads();
    }
    l += __shfl_xor(l, 32);
    if (hi == 0) wsf[r32] = 1.f / l;
    float rl[16];
#pragma unroll
    for (int r = 0; r < 16; ++r) rl[r] = wsf[crow(r, hi)];
    if (MODE == 0) {
        LAS float* X = (LAS float*)lds;
        static_assert(MODE != 0 || 4 * 64 * 64 * 4 <= WSOFF, "exchange must not overlap the per-wave scratch");
        if (comp == 1) {
#pragma unroll
            for (int d = 0; d < NDB; ++d)
#pragma unroll
                for (int r = 0; r < 16; ++r) X[(qw * 64 + d * 16 + r) * 64 + lane] = o[d][r] * rl[r] * lam;
        }
        __syncthreads();
        if (comp == 0) {
            float ss[16];
#pragma unroll
            for (int r = 0; r < 16; ++r) ss[r] = 0.f;
#pragma unroll
            for (int d = 0; d < NDB; ++d)
#pragma unroll
                for (int r = 0; r < 16; ++r) { const float a = o[d][r] * rl[r] - X[(qw * 64 + d * 16 + r) * 64 + lane]; o[d][r] = a; ss[r] += a * a; }
#pragma unroll
            for (int r = 0; r < 16; ++r) { float s = ss[r];
#pragma unroll
                for (int x = 1; x < 32; x <<= 1) s += __shfl_xor(s, x);
                ss[r] = rsqrtf(s * (1.f / 128.f) + LN_EPS) * 0.8f; }
            float gd[NDB];
#pragma unroll
            for (int d = 0; d < NDB; ++d) gd[d] = diff_g[32 * d + r32];
            __syncthreads();
            LAS bf16_t* st = (LAS bf16_t*)lds + qw * 32 * 136;
#pragma unroll
            for (int d = 0; d < NDB; ++d)
#pragma unroll
                for (int r = 0; r < 16; ++r) st[crow(r, hi) * 136 + 32 * d + r32] = (bf16_t)f2bf(o[d][r] * ss[r] * gd[d]);
            asm volatile("s_waitcnt lgkmcnt(0)" ::: "memory");
            bf16_t* yp = Y + (size_t)(b * SEQ + q0w) * DM + h * 128;
#pragma unroll
            for (int i = 0; i < 8; ++i) { const int row = i * 4 + (lane >> 4), ch = lane & 15; *(v4u*)(yp + (size_t)row * DM + ch * 8) = *(const LAS v4u*)(st + row * 136 + ch * 8); }
        } else {
            __syncthreads();
        }
    } else {
        LAS bf16_t* st = (LAS bf16_t*)lds + wave * 32 * 72;
#pragma unroll
        for (int d = 0; d < NDB; ++d)
#pragma unroll
            for (int r = 0; r < 16; ++r) st[crow(r, hi) * 72 + 32 * d + r32] = (bf16_t)f2bf(o[d][r] * rl[r]);
        asm volatile("s_waitcnt lgkmcnt(0)" ::: "memory");
        bf16_t* yp = Y + (size_t)(b * SEQ + q0w) * DM + h * 64;
#pragma unroll
        for (int i = 0; i < 4; ++i) { const int row = i * 8 + (lane >> 3), ch = lane & 7; *(v4u*)(yp + (size_t)row * DM + ch * 8) = *(const LAS v4u*)(st + row * 72 + ch * 8); }
    }
    __syncthreads();
#undef ATT_GLOAD
#undef ATT_LSTORE
}

__device__ __forceinline__ void cum_scan(LAS unsigned char* lds, const float* __restrict__ LF, const float* __restrict__ bfg, float* __restrict__ cum, int bh) {
    int tid_ = threadIdx.x; asm volatile("" : "+v"(tid_));
    const int tid = tid_, lane = tid & 63, wave = tid >> 6, b = bh >> 4, h = bh & 15;
    LAS float* wt = (LAS float*)lds;
    const float bias = bfg[h];
    float v[4], run = 0.f;
#pragma unroll
    for (int i = 0; i < 4; ++i) { const float z = LF[(size_t)(b * SEQ + 4 * tid + i) * 16 + h] + bias; run += fminf(z, 0.f) - log1pf(expf(-fabsf(z))); v[i] = run; }
    float inc = run;
#pragma unroll
    for (int o = 1; o < 64; o <<= 1) { const float y = __shfl_up(inc, o); if (lane >= o) inc += y; }
    if (lane == 63) wt[wave] = inc;
    __syncthreads();
    float base = inc - run;
    for (int w = 0; w < wave; ++w) base += wt[w];
    float* cp = cum + (size_t)bh * SEQ + 4 * tid;
    *(f32x4*)cp = (f32x4){(base + v[0]) * LOG2E, (base + v[1]) * LOG2E, (base + v[2]) * LOG2E, (base + v[3]) * LOG2E};
    __syncthreads();
}
}
namespace ret {
using att::crow; using att::vtr; using att::cvtpk;
__device__ __forceinline__ void r1_unit(LAS unsigned char* lds, const bf16_t* __restrict__ UB, float* __restrict__ KVT, int b, int h, int n) {
    constexpr int VSTR = 272, KSTR = 144, VOFF = 0, KOFF = 128 * VSTR;
    int tid_ = threadIdx.x; asm volatile("" : "+v"(tid_));
    const int tid = tid_, lane = tid & 63, wave = __builtin_amdgcn_readfirstlane(tid >> 6), r32 = lane & 31, hi = lane >> 5, i16 = lane & 15, g1 = (lane >> 4) & 1;
    const float l2g = log2f(1.f - exp2f(-5.f - (float)h));
    const bf16_t* Ub = UB + (size_t)(b * SEQ + n * 128) * UBW;
#pragma unroll
    for (int c = 0; c < 4; ++c) { const int ci = tid + 512 * c, row = ci >> 4, ch = ci & 15; *(LAS v4u*)(lds + VOFF + row * VSTR + ch * 16) = *(const v4u*)(Ub + (size_t)row * UBW + 2048 + h * 128 + ch * 8); }
#pragma unroll
    for (int c = 0; c < 2; ++c) { const int ci = tid + 512 * c, row = ci >> 3, ch = ci & 7; const v4u w = *(const v4u*)(Ub + (size_t)row * UBW + 1792 + h * 64 + ch * 8);
        const float dk = exp2f((float)(127 - row) * l2g); v4u o;
        o.x = pk2(bflo(w.x) * dk, bfhi(w.x) * dk); o.y = pk2(bflo(w.y) * dk, bfhi(w.y) * dk); o.z = pk2(bflo(w.z) * dk, bfhi(w.z) * dk); o.w = pk2(bflo(w.w) * dk, bfhi(w.w) * dk);
        *(LAS v4u*)(lds + KOFF + row * KSTR + ch * 16) = o; }
    __syncthreads();
    const int eb = wave & 3, db = wave >> 2;
    const LAS unsigned char* Vb = lds + VOFF + (8 * hi + (i16 >> 2)) * VSTR + (32 * eb + 16 * g1 + 4 * (i16 & 3)) * 2;
    const LAS unsigned char* Kb = lds + KOFF + (8 * hi + (i16 >> 2)) * KSTR + (32 * db + 16 * g1 + 4 * (i16 & 3)) * 2;
    f32x16 acc;
#pragma unroll
    for (int r = 0; r < 16; ++r) acc[r] = 0.f;
#pragma unroll
    for (int ks = 0; ks < 8; ++ks) {
        const s16x4 a0 = vtr(Vb + (16 * ks) * VSTR), a1 = vtr(Vb + (16 * ks + 4) * VSTR), b0 = vtr(Kb + (16 * ks) * KSTR), b1 = vtr(Kb + (16 * ks + 4) * KSTR);
        const bf16x8 af = {a0[0], a0[1], a0[2], a0[3], a1[0], a1[1], a1[2], a1[3]}, bf = {b0[0], b0[1], b0[2], b0[3], b1[0], b1[1], b1[2], b1[3]};
        acc = __builtin_amdgcn_mfma_f32_32x32x16_bf16(af, bf, acc, 0, 0, 0);
    }
    float* kv = KVT + (size_t)(((b * 4 + h) * 16 + n)) * 8192;
#pragma unroll
    for (int r = 0; r < 16; ++r) kv[(32 * eb + crow(r, hi)) * 64 + 32 * db + r32] = acc[r];
    __syncthreads();
}

__device__ __forceinline__ void r2_unit(LAS unsigned char* lds, const bf16_t* __restrict__ UB, const float* __restrict__ KVT, bf16_t* __restrict__ Y, const float* __restrict__ ret_g, int b, int h, int n) {
    constexpr int KSTR = 144, VSTR = 272, SSTR = 144, KOFF = 0, VOFF = 128 * KSTR, SOFF = VOFF + 128 * VSTR, OSTR = 132 * 4;
    int tid_ = threadIdx.x; asm volatile("" : "+v"(tid_));
    const int tid = tid_, lane = tid & 63, wave = __builtin_amdgcn_readfirstlane(tid >> 6), r32 = lane & 31, hi = lane >> 5, i16 = lane & 15, g1 = (lane >> 4) & 1;
    const float l2g = log2f(1.f - exp2f(-5.f - (float)h)), cd = exp2f(128.f * l2g);
    const bf16_t* Ub = UB + (size_t)(b * SEQ + n * 128) * UBW;
#pragma unroll
    for (int c = 0; c < 2; ++c) { const int ci = tid + 512 * c, row = ci >> 3, ch = ci & 7; *(LAS v4u*)(lds + KOFF + row * KSTR + ch * 16) = *(const v4u*)(Ub + (size_t)row * UBW + 1792 + h * 64 + ch * 8); }
#pragma unroll
    for (int c = 0; c < 4; ++c) { const int ci = tid + 512 * c, row = ci >> 4, ch = ci & 15; *(LAS v4u*)(lds + VOFF + row * VSTR + ch * 16) = *(const v4u*)(Ub + (size_t)row * UBW + 2048 + h * 128 + ch * 8); }
    {
        const int e = tid >> 2, d0 = (tid & 3) * 16; f32x4 st[4];
#pragma unroll
        for (int i = 0; i < 4; ++i) st[i] = (f32x4){0.f, 0.f, 0.f, 0.f};
        const float* kv = KVT + (size_t)((b * 4 + h) * 16) * 8192 + e * 64 + d0;
        for (int m = 0; m < n; ++m) {
#pragma unroll
            for (int i = 0; i < 4; ++i) st[i] = st[i] * cd + *(const f32x4*)(kv + (size_t)m * 8192 + 4 * i); }
        v4u w0, w1; w0.x = pk2(st[0][0], st[0][1]); w0.y = pk2(st[0][2], st[0][3]); w0.z = pk2(st[1][0], st[1][1]); w0.w = pk2(st[1][2], st[1][3]);
        w1.x = pk2(st[2][0], st[2][1]); w1.y = pk2(st[2][2], st[2][3]); w1.z = pk2(st[3][0], st[3][1]); w1.w = pk2(st[3][2], st[3][3]);
        *(LAS v4u*)(lds + SOFF + e * SSTR + d0 * 2) = w0; *(LAS v4u*)(lds + SOFF + e * SSTR + d0 * 2 + 16) = w1;
    }
    __syncthreads();
    f32x16 o[4];
    const int rb = wave;
    if (wave < 4) {
        const int c = 32 * rb + r32;
        bf16x8 qf[4];
        { const bf16_t* qp = Ub + (size_t)c * UBW + 1536 + h * 64 + 8 * hi;
#pragma unroll
          for (int ks = 0; ks < 4; ++ks) qf[ks] = *(const bf16x8*)(qp + 16 * ks); }
#pragma unroll
        for (int eb = 0; eb < 4; ++eb)
#pragma unroll
            for (int r = 0; r < 16; ++r) o[eb][r] = 0.f;
        const LAS unsigned char* Vb = lds + VOFF + (4 * hi + (i16 >> 2)) * VSTR + (16 * g1 + 4 * (i16 & 3)) * 2;
#pragma unroll
        for (int mb = 0; mb < 4; ++mb) {
            if (mb <= rb) {
                f32x16 p;
#pragma unroll
                for (int r = 0; r < 16; ++r) p[r] = 0.f;
                const LAS unsigned char* Kb = lds + KOFF + (32 * mb + r32) * KSTR + (8 * hi) * 2;
#pragma unroll
                for (int ks = 0; ks < 4; ++ks) p = __builtin_amdgcn_mfma_f32_32x32x16_bf16(*(const LAS bf16x8*)(Kb + ks * 32), qf[ks], p, 0, 0, 0);
#pragma unroll
                for (int r = 0; r < 16; ++r) { const int dd = c - (32 * mb + crow(r, hi)); p[r] = dd >= 0 ? p[r] * exp2f((float)dd * l2g) : 0.f; }
                bf16x8 pa[2];
#pragma unroll
                for (int s = 0; s < 2; ++s) { v4u w; w.x = cvtpk(p[8 * s + 0], p[8 * s + 1]); w.y = cvtpk(p[8 * s + 2], p[8 * s + 3]); w.z = cvtpk(p[8 * s + 4], p[8 * s + 5]); w.w = cvtpk(p[8 * s + 6], p[8 * s + 7]); pa[s] = __builtin_bit_cast(bf16x8, w); }
#pragma unroll
                for (int eb = 0; eb < 4; ++eb)
#pragma unroll
                    for (int s = 0; s < 2; ++s) {
                        const s16x4 lo = vtr(Vb + (32 * mb + 16 * s) * VSTR + eb * 64), hh = vtr(Vb + (32 * mb + 16 * s + 8) * VSTR + eb * 64);
                        const bf16x8 vf = {lo[0], lo[1], lo[2], lo[3], hh[0], hh[1], hh[2], hh[3]};
                        o[eb] = __builtin_amdgcn_mfma_f32_32x32x16_bf16(pa[s], vf, o[eb], 0, 0, 0);
                    }
            }
        }
        if (n > 0) {
            float gq[16];
#pragma unroll
            for (int r = 0; r < 16; ++r) gq[r] = exp2f((float)(32 * rb + crow(r, hi) + 1) * l2g);
#pragma unroll
            for (int eb = 0; eb < 4; ++eb) {
                f32x16 x;
#pragma unroll
                for (int r = 0; r < 16; ++r) x[r] = 0.f;
                const LAS unsigned char* Sb = lds + SOFF + (32 * eb + r32) * SSTR + (8 * hi) * 2;
#pragma unroll
                for (int ks = 0; ks < 4; ++ks) x = __builtin_amdgcn_mfma_f32_32x32x16_bf16(qf[ks], *(const LAS bf16x8*)(Sb + ks * 32), x, 0, 0, 0);
#pragma unroll
                for (int r = 0; r < 16; ++r) o[eb][r] += gq[r] * x[r];
            }
        }
#pragma unroll
        for (int r = 0; r < 16; ++r) {
            float s = (o[0][r] + o[1][r]) + (o[2][r] + o[3][r]);
#pragma unroll
            for (int x = 1; x < 32; x <<= 1) s += __shfl_xor(s, x);
            const float mu = s * (1.f / 128.f);
            float q = 0.f;
#pragma unroll
            for (int eb = 0; eb < 4; ++eb) { o[eb][r] -= mu; q += o[eb][r] * o[eb][r]; }
#pragma unroll
            for (int x = 1; x < 32; x <<= 1) q += __shfl_xor(q, x);
            const float rs = rsqrtf(q * (1.f / 128.f) + LN_EPS);
#pragma unroll
            for (int eb = 0; eb < 4; ++eb) o[eb][r] *= rs;
        }
    }
    __syncthreads();
    if (wave < 4) {
        LAS float* st = (LAS float*)(lds + rb * 32 * OSTR);
#pragma unroll
        for (int eb = 0; eb < 4; ++eb) { const float ge = ret_g[32 * eb + r32];
#pragma unroll
            for (int r = 0; r < 16; ++r) st[crow(r, hi) * 132 + 32 * eb + r32] = o[eb][r] * ge; }
        asm volatile("s_waitcnt lgkmcnt(0)" ::: "memory");
#pragma unroll
        for (int i = 0; i < 16; ++i) {
            const int row = 2 * i + hi, ch = r32;
            const f32x4 v = *(const LAS f32x4*)(st + row * 132 + 4 * ch);
            const v2u gw = *(const v2u*)(Ub + (size_t)(32 * rb + row) * UBW + 2560 + h * 128 + 4 * ch);
            const float g0 = bflo(gw.x), g1_ = bfhi(gw.x), g2 = bflo(gw.y), g3 = bfhi(gw.y);
            v2u ow; ow.x = pk2(silu_f(g0) * v[0], silu_f(g1_) * v[1]); ow.y = pk2(silu_f(g2) * v[2], silu_f(g3) * v[3]);
            *(v2u*)(Y + (size_t)(b * SEQ + n * 128 + 32 * rb + row) * DM + 512 + h * 128 + 4 * ch) = ow;
        }
    }
    __syncthreads();
}
}
namespace nv {
template <class TA, class TC>
__global__ __launch_bounds__(256) void gemm_nv(const TA* __restrict__ A, int lda, const float* __restrict__ B, int ldb, TC* __restrict__ C, int ldc, int M, int N, int K, float sc, int nsc) {
    __shared__ float As[16][68];
    __shared__ float Bs[16][68];
    const int tid = threadIdx.x, tx = tid & 15, ty = tid >> 4;
    const int m0 = blockIdx.y * 64, n0 = blockIdx.x * 64;
    float acc[4][4];
#pragma unroll
    for (int i = 0; i < 4; ++i)
#pragma unroll
        for (int j = 0; j < 4; ++j) acc[i][j] = 0.f;
    for (int k0 = 0; k0 < K; k0 += 16) {
        { const int r = tid >> 2, c = (tid & 3) * 4; const TA* ap = A + (size_t)(m0 + r) * lda + k0 + c;
          As[c][r] = ldv(ap); As[c + 1][r] = ldv(ap + 1); As[c + 2][r] = ldv(ap + 2); As[c + 3][r] = ldv(ap + 3); }
        { const int r = tid >> 4, c = (tid & 15) * 4, n = n0 + c; float4 v = make_float4(0.f, 0.f, 0.f, 0.f);
          if (n < N) v = *(const float4*)(B + (size_t)(k0 + r) * ldb + n);
          Bs[r][c] = v.x; Bs[r][c + 1] = v.y; Bs[r][c + 2] = v.z; Bs[r][c + 3] = v.w; }
        __syncthreads();
#pragma unroll
        for (int kk = 0; kk < 16; ++kk) {
            float a[4], b[4];
#pragma unroll
            for (int i = 0; i < 4; ++i) a[i] = As[kk][ty * 4 + i];
#pragma unroll
            for (int j = 0; j < 4; ++j) b[j] = Bs[kk][tx * 4 + j];
#pragma unroll
            for (int i = 0; i < 4; ++i)
#pragma unroll
                for (int j = 0; j < 4; ++j) acc[i][j] += a[i] * b[j];
        }
        __syncthreads();
    }
#pragma unroll
    for (int i = 0; i < 4; ++i) { const int m = m0 + ty * 4 + i, n = n0 + tx * 4;
        if (n < N) {
#pragma unroll
            for (int j = 0; j < 4; ++j) stv(C + (size_t)m * ldc + n + j, acc[i][j] * ((n + j) < nsc ? sc : 1.f)); } }
}
template <class TA, class TC>
inline void gemm(hipStream_t st, const TA* A, int lda, const float* B, int ldb, TC* C, int ldc, int M, int N, int K, float sc = 1.f, int nsc = 0) {
    hipLaunchKernelGGL((gemm_nv<TA, TC>), dim3((N + 63) / 64, M / 64), dim3(256), 0, st, A, lda, B, ldb, C, ldc, M, N, K, sc, nsc);
}

__global__ void rope_apply(bf16_t* UB, const float2* rope) {
    const int gid = blockIdx.x * blockDim.x + threadIdx.x;
    if (gid >= T * 4 * 32) return;
    const int i = gid & 31, h = (gid >> 5) & 3, t = gid >> 7, s = t % SEQ;
    const float2 cs = rope[s * 32 + i];
    bf16_t* q = UB + (size_t)t * UBW + 1536 + h * 64; bf16_t* k = UB + (size_t)t * UBW + 1792 + h * 64;
    const float q1 = bf2f(q[i]), q2 = bf2f(q[i + 32]);
    stv(q + i, q1 * cs.x - q2 * cs.y); stv(q + i + 32, q2 * cs.x + q1 * cs.y);
    const float k1 = bf2f(k[i]), k2 = bf2f(k[i + 32]);
    stv(k + i, (k1 * cs.x - k2 * cs.y) * 0.125f); stv(k + i + 32, (k2 * cs.x + k1 * cs.y) * 0.125f);
}

__device__ __forceinline__ float dot64(const float* __restrict__ qs, const bf16_t* __restrict__ kp) {
    float acc = 0.f;
#pragma unroll
    for (int d = 0; d < 64; d += 8) { const v4u w = *(const v4u*)(kp + d);
        acc += qs[d] * bflo(w.x) + qs[d + 1] * bfhi(w.x) + qs[d + 2] * bflo(w.y) + qs[d + 3] * bfhi(w.y) + qs[d + 4] * bflo(w.z) + qs[d + 5] * bfhi(w.z) + qs[d + 6] * bflo(w.w) + qs[d + 7] * bfhi(w.w); }
    return acc;
}

__global__ __launch_bounds__(64) void diff_attn_nv(const bf16_t* __restrict__ UB, bf16_t* __restrict__ Y, const float* __restrict__ bt, const float* __restrict__ lamp, const float* __restrict__ diff_g) {
    __shared__ float sc1[SEQ];
    __shared__ float sc2[SEQ];
    __shared__ float qs[128];
    const int lane = threadIdx.x;
    const int idx = blockIdx.x, q = idx % SEQ, h = (idx / SEQ) % 4, b = idx / (SEQ * 4);
    const bf16_t* Ub = UB + (size_t)b * SEQ * UBW;
    qs[lane] = bf2f(Ub[(size_t)q * UBW + h * 128 + lane]); qs[lane + 64] = bf2f(Ub[(size_t)q * UBW + h * 128 + 64 + lane]);
    __syncthreads();
    const float lam = lamp[0];
    float m1 = -INFINITY, m2 = -INFINITY;
    for (int k = lane; k <= q; k += 64) {
        const bf16_t* kp = Ub + (size_t)k * UBW + 512 + h * 128;
        int dist = q - k; if (dist > 127) dist = 127;
        const float bias = bt[h * 128 + dist];
        const float s1 = dot64(qs, kp) + bias, s2 = dot64(qs + 64, kp + 64) + bias;
        sc1[k] = s1; sc2[k] = s2; m1 = fmaxf(m1, s1); m2 = fmaxf(m2, s2);
    }
    m1 = wave_max(m1); m2 = wave_max(m2);
    float l1 = 0.f, l2 = 0.f;
    for (int k = lane; k <= q; k += 64) { const float e1 = exp2f(sc1[k] - m1), e2 = exp2f(sc2[k] - m2); sc1[k] = e1; sc2[k] = e2; l1 += e1; l2 += e2; }
    l1 = wave_sum(l1); l2 = wave_sum(l2);
    const float r1 = 1.f / l1, r2 = lam / l2;
    for (int k = lane; k <= q; k += 64) sc1[k] = sc1[k] * r1 - sc2[k] * r2;
    __syncthreads();
    float a0 = 0.f, a1 = 0.f;
    const bf16_t* vp = Ub + 1024 + h * 128 + lane;
    for (int k = 0; k <= q; ++k) { const float a = sc1[k]; a0 += a * bf2f(vp[(size_t)k * UBW]); a1 += a * bf2f(vp[(size_t)k * UBW + 64]); }
    const float ss = wave_sum(a0 * a0 + a1 * a1);
    const float r = rsqrtf(ss * (1.f / 128.f) + LN_EPS) * 0.8f;
    bf16_t* yp = Y + (size_t)(b * SEQ + q) * DM + h * 128;
    stv(yp + lane, a0 * r * diff_g[lane]); stv(yp + lane + 64, a1 * r * diff_g[lane + 64]);
}

__global__ __launch_bounds__(64) void retention_nv(const bf16_t* __restrict__ UB, bf16_t* __restrict__ Y, const float* __restrict__ ret_g) {
    __shared__ float sc[SEQ];
    __shared__ float qs[64];
    const int lane = threadIdx.x;
    const int idx = blockIdx.x, t = idx % SEQ, h = (idx / SEQ) % 4, b = idx / (SEQ * 4);
    const bf16_t* Ub = UB + (size_t)b * SEQ * UBW;
    qs[lane] = bf2f(Ub[(size_t)t * UBW + 1536 + h * 64 + lane]);
    __syncthreads();
    const float log_g = log1pf(-exp2f(-5.0f - (float)h));
    for (int k = lane; k <= t; k += 64) sc[k] = dot64(qs, Ub + (size_t)k * UBW + 1792 + h * 64) * expf((float)(t - k) * log_g);
    __syncthreads();
    float a0 = 0.f, a1 = 0.f;
    const bf16_t* vp = Ub + 2048 + h * 128 + lane;
    for (int k = 0; k <= t; ++k) { const float a = sc[k]; a0 += a * bf2f(vp[(size_t)k * UBW]); a1 += a * bf2f(vp[(size_t)k * UBW + 64]); }
    const float mu = wave_sum(a0 + a1) * (1.f / 128.f);
    const float d0 = a0 - mu, d1 = a1 - mu;
    const float var = wave_sum(d0 * d0 + d1 * d1) * (1.f / 128.f);
    const float r = rsqrtf(var + LN_EPS);
    const bf16_t* gp = Ub + (size_t)t * UBW + 2560 + h * 128;
    const float g0 = bf2f(gp[lane]), g1 = bf2f(gp[lane + 64]);
    bf16_t* yp = Y + (size_t)(b * SEQ + t) * DM + 512 + h * 128;
    stv(yp + lane, silu_f(g0) * (d0 * r * ret_g[lane])); stv(yp + lane + 64, silu_f(g1) * (d1 * r * ret_g[lane + 64]));
}

template <class TB>
__global__ __launch_bounds__(256) void ln_nv(const float* a, const TB* __restrict__ bsrc, const float* __restrict__ g, const float* __restrict__ beta, float* out, bf16_t* __restrict__ outb) {
    const int lane = threadIdx.x & 63, row = blockIdx.x * 4 + (threadIdx.x >> 6);
    float v[16]; float s = 0.f;
#pragma unroll
    for (int j = 0; j < 16; ++j) { const int c = lane + 64 * j; v[j] = ALPHA * a[(size_t)row * DM + c] + ldv(bsrc + (size_t)row * DM + c); s += v[j]; }
    const float mu = wave_sum(s) * (1.f / DM);
    float q = 0.f;
#pragma unroll
    for (int j = 0; j < 16; ++j) { v[j] -= mu; q += v[j] * v[j]; }
    const float r = rsqrtf(wave_sum(q) * (1.f / DM) + LN_EPS);
#pragma unroll
    for (int j = 0; j < 16; ++j) { const int c = lane + 64 * j; const float o = v[j] * r * g[c] + beta[c]; out[(size_t)row * DM + c] = o; stv(outb + (size_t)row * DM + c, o); }
}

__global__ __launch_bounds__(256) void moe_nv(const float* __restrict__ H, const float* __restrict__ router_w, const float* __restrict__ Wg, const float* __restrict__ Wu, const float* __restrict__ Wd, float* __restrict__ F) {
    __shared__ float hs[DM];
    __shared__ float as[512];
    __shared__ float logit[16];
    __shared__ float p[16];
    __shared__ int sel_e[2];
    __shared__ float sel_g[2];
    const int tid = threadIdx.x, lane = tid & 63, w = tid >> 6, tok = blockIdx.x;
    for (int c = tid; c < DM; c += 256) hs[c] = H[(size_t)tok * DM + c];
    __syncthreads();
    for (int e = w * 4; e < w * 4 + 4; ++e) { float s = 0.f; for (int k = lane; k < DM; k += 64) s += hs[k] * router_w[k * 16 + e]; s = wave_sum(s); if (lane == 0) logit[e] = s; }
    __syncthreads();
    if (tid == 0) {
        float mx = -INFINITY; for (int e = 0; e < 16; ++e) mx = fmaxf(mx, logit[e]);
        float sum = 0.f; for (int e = 0; e < 16; ++e) { p[e] = expf(logit[e] - mx); sum += p[e]; }
        for (int e = 0; e < 16; ++e) p[e] /= sum;
        int best = 0; float bs = -1.f; int bi0 = 0, bi1 = 1;
        for (int g = 0; g < 4; ++g) {
            int i0 = 0; for (int j = 1; j < 4; ++j) if (p[g * 4 + j] > p[g * 4 + i0]) i0 = j;
            int i1 = (i0 == 0) ? 1 : 0; for (int j = 0; j < 4; ++j) if (j != i0 && p[g * 4 + j] > p[g * 4 + i1]) i1 = j;
            const float sc = p[g * 4 + i0] + p[g * 4 + i1];
            if (sc > bs) { bs = sc; best = g; bi0 = i0; bi1 = i1; }
        }
        const float v0 = p[best * 4 + bi0], v1 = p[best * 4 + bi1];
        sel_e[0] = best * 4 + bi0; sel_e[1] = best * 4 + bi1; sel_g[0] = v0 / (v0 + v1); sel_g[1] = v1 / (v0 + v1);
    }
    __syncthreads();
    float y[4] = {0.f, 0.f, 0.f, 0.f};
    for (int kk = 0; kk < 2; ++kk) {
        const int e = sel_e[kk]; const float gt = sel_g[kk];
        const float* wg = Wg + (size_t)e * DM * 512; const float* wu = Wu + (size_t)e * DM * 512; const float* wd = Wd + (size_t)e * 512 * DM;
        float g0 = 0.f, g1 = 0.f, u0 = 0.f, u1 = 0.f;
        for (int k = 0; k < DM; ++k) { const float hv = hs[k];
            g0 += hv * wg[(size_t)k * 512 + tid]; g1 += hv * wg[(size_t)k * 512 + tid + 256]; u0 += hv * wu[(size_t)k * 512 + tid]; u1 += hv * wu[(size_t)k * 512 + tid + 256]; }
        __syncthreads();
        as[tid] = (g0 / (1.f + expf(-g0))) * u0; as[tid + 256] = (g1 / (1.f + expf(-g1))) * u1;
        __syncthreads();
        float o0 = 0.f, o1 = 0.f, o2 = 0.f, o3 = 0.f;
        for (int k = 0; k < 512; ++k) { const float av = as[k];
            o0 += av * wd[(size_t)k * DM + tid]; o1 += av * wd[(size_t)k * DM + tid + 256]; o2 += av * wd[(size_t)k * DM + tid + 512]; o3 += av * wd[(size_t)k * DM + tid + 768]; }
        y[0] += gt * o0; y[1] += gt * o1; y[2] += gt * o2; y[3] += gt * o3;
    }
#pragma unroll
    for (int j = 0; j < 4; ++j) F[(size_t)tok * DM + tid + 256 * j] = y[j];
}

__global__ void ple_final(const float* Hh, const float* __restrict__ G, const bf16_t* __restrict__ PP, float* out, bf16_t* __restrict__ outb, int n) {
    const int gid = blockIdx.x * blockDim.x + threadIdx.x;
    if (gid >= n) return;
    const float o = Hh[gid] + sigmoid_f(G[gid]) * bf2f(PP[gid]);
    out[gid] = o; stv(outb + gid, o);
}

__global__ void fox_cum(const float* __restrict__ LF, const float* __restrict__ bf, float* __restrict__ cum) {
    const int gid = blockIdx.x * blockDim.x + threadIdx.x;
    if (gid >= BATCH * 16) return;
    const int h = gid & 15, b = gid >> 4;
    float c = 0.f;
    for (int s = 0; s < SEQ; ++s) { const float z = LF[(size_t)(b * SEQ + s) * 16 + h] + bf[h]; c += fminf(z, 0.f) - log1pf(expf(-fabsf(z))); cum[(size_t)gid * SEQ + s] = c * LOG2E; }
}
__global__ __launch_bounds__(64) void fox_attn_nv(const bf16_t* __restrict__ UB, const float* __restrict__ cum, bf16_t* __restrict__ Y) {
    __shared__ float sc[SEQ];
    __shared__ float qs[64];
    const int lane = threadIdx.x;
    const int idx = blockIdx.x, q = idx % SEQ, h = (idx / SEQ) % 16, b = idx / (SEQ * 16);
    const bf16_t* Ub = UB + (size_t)b * SEQ * UBW;
    const float* cb = cum + (size_t)(b * 16 + h) * SEQ;
    qs[lane] = bf2f(Ub[(size_t)q * UBW + h * 64 + lane]);
    __syncthreads();
    const float cq = cb[q];
    float m = -INFINITY;
    for (int k = lane; k <= q; k += 64) { const float s = dot64(qs, Ub + (size_t)k * UBW + 1024 + h * 64) + cq - cb[k]; sc[k] = s; m = fmaxf(m, s); }
    m = wave_max(m);
    float l = 0.f;
    for (int k = lane; k <= q; k += 64) { const float e = exp2f(sc[k] - m); sc[k] = e; l += e; }
    l = wave_sum(l);
    __syncthreads();
    float a0 = 0.f;
    const bf16_t* vp = Ub + 2048 + h * 64 + lane;
    for (int k = 0; k <= q; ++k) a0 += sc[k] * bf2f(vp[(size_t)k * UBW]);
    stv(Y + (size_t)(b * SEQ + q) * DM + h * 64 + lane, a0 / l);
}
__global__ __launch_bounds__(256) void moe_slots_nv(const bf16_t* __restrict__ HB, const unsigned* __restrict__ cnt, const int* __restrict__ list, const float* __restrict__ listg,
                                                     const float* __restrict__ Wg, const float* __restrict__ Wu, const float* __restrict__ Wd, bf16_t* __restrict__ YS) {
    __shared__ float hs[DM];
    __shared__ float as[512];
    const int tid = threadIdx.x, slot = blockIdx.x;
    int e = 0, off = 0;
    for (int k = 0; k < 16; ++k) { const int c = (int)cnt[64 * k]; if (slot >= off + c) { off += c; e = k + 1; } else break; }
    if (e >= 16) return;
    const int pos = slot - off, token = list[e * T + pos]; const float gt = listg[e * T + pos];
    for (int c = tid; c < DM; c += 256) hs[c] = bf2f(HB[(size_t)token * DM + c]);
    __syncthreads();
    const float* wg = Wg + (size_t)e * DM * 512; const float* wu = Wu + (size_t)e * DM * 512; const float* wd = Wd + (size_t)e * 512 * DM;
    float g0 = 0.f, g1 = 0.f, u0 = 0.f, u1 = 0.f;
    for (int k = 0; k < DM; ++k) { const float hv = hs[k];
        g0 += hv * wg[(size_t)k * 512 + tid]; g1 += hv * wg[(size_t)k * 512 + tid + 256]; u0 += hv * wu[(size_t)k * 512 + tid]; u1 += hv * wu[(size_t)k * 512 + tid + 256]; }
    as[tid] = silu_f(g0) * u0; as[tid + 256] = silu_f(g1) * u1;
    __syncthreads();
    float o0 = 0.f, o1 = 0.f, o2 = 0.f, o3 = 0.f;
    for (int k = 0; k < 512; ++k) { const float av = as[k];
        o0 += av * wd[(size_t)k * DM + tid]; o1 += av * wd[(size_t)k * DM + tid + 256]; o2 += av * wd[(size_t)k * DM + tid + 512]; o3 += av * wd[(size_t)k * DM + tid + 768]; }
    bf16_t* y = YS + (size_t)slot * DM;
    stv(y + tid, gt * o0); stv(y + tid + 256, gt * o1); stv(y + tid + 512, gt * o2); stv(y + tid + 768, gt * o3);
}
}
constexpr int NPH = 19;
#ifndef MEGA_MASK
#define MEGA_MASK 0x3
#endif
__host__ __device__ constexpr bool is_mega(int ph) { return ((MEGA_MASK >> ph) & 1) != 0; }

__global__ void __launch_bounds__(NWAVES * 64, 2) mega_fwd(Args args) {
    extern __shared__ __attribute__((aligned(16))) unsigned char lds[];
    Frame F;
    F.lds = (LAS unsigned char*)lds;
    F.MISC = (volatile LAS unsigned*)(F.lds + MISC_OFF);
    F.tid = threadIdx.x; F.lane = F.tid & 63; F.wave = __builtin_amdgcn_readfirstlane(F.tid >> 6);
    F.G = gridDim.x; { const int bx = blockIdx.x; F.vcu = (F.G % 8 == 0) ? (bx % 8) * (F.G / 8) + bx / 8 : bx; }
    F.ws = args.ws; F.ctl = (unsigned*)(args.ws + WS_CTL);
    for (int u = F.tid; u < (LDS_BYTES - LDSCTL_OFF) / 4; u += NWAVES * 64) ((LAS unsigned*)(F.lds + LDSCTL_OFF))[u] = 0u;
    __syncthreads();
    const int lo = args.ph_lo, hi = args.ph_hi;
    XcdBarrier bar; bar.bar = F.ctl + CW_BAR + args.li * XCD_BAR_WORDS; bar.x = 0; bar.st = nullptr;
    if (hi - lo > 1 || (lo <= 3 && 3 < hi)) bar = xcd_barrier_post(F.ctl + CW_BAR + args.li * XCD_BAR_WORDS, F.MISC + 8);
#define GRID_BAR() xcd_barrier(bar)
    if constexpr (is_mega(0)) { if (lo == 0) { F.ws = args.ws; p0_prologue(F, args); if (hi > 1) GRID_BAR(); } }
#pragma nounroll
    for (int ph = (lo == 0 ? 1 : lo); ph < hi; ++ph) {
        { int t_ = threadIdx.x; asm volatile("" : "+v"(t_)); F.tid = t_; F.lane = t_ & 63; }
        unsigned char* ws = args.ws; asm volatile("" : "+s"(ws)); F.ws = ws; F.ctl = (unsigned*)(ws + WS_CTL);
        const int layer = ph >= 10 ? 1 : 0, q = ph >= 10 ? ph - 9 : ph;
        unsigned* cnt = F.ctl + CW_CNT + layer * 16 * 64;
        TokEP* tok_ep = (TokEP*)(ws + WS_TOK); float2* tok_g = (float2*)(ws + WS_TOK + 512 * 1024); int* list = (int*)(ws + WS_LIST); float* listg = (float*)(ws + WS_LISTG);
        if (q == 1) {
            if (layer == 0) { if constexpr (is_mega(1)) {
                pg8::DenseOrder S; S.init(ws + WS_D, ws + W_IN0, T, EVEN_IN, DM, F.G, (int)blockIdx.x);
                pg8::EpiIn0 E{(bf16_t*)(ws + WS_A), (const float2*)(ws + WS_ROPE)};
                pg8::gemm_phase<pg8::EpiIn0, pg8::DenseOrder, true, false>(F.lds + RING_OFF, DM, S, E); }
            } else { if constexpr (is_mega(10)) {
                pg8::DenseOrder S; S.init(ws + WS_D, ws + W_IN1, T, 3328, DM, F.G, (int)blockIdx.x);
                pg8::EpiIn1 E{(bf16_t*)(ws + WS_A), (float*)(ws + WS_LF)};
                pg8::gemm_phase<pg8::EpiIn1, pg8::DenseOrder, true, false>(F.lds + RING_OFF, DM, S, E); }
            }
        } else if (q == 2) {
            if (layer == 0) { if constexpr (is_mega(2)) {
                const int bh = F.vcu >> 3, s = F.vcu & 7; const float lam = *(const float*)(ws + WS_LAM);
                att::attn_unit<0>(F.lds, (const bf16_t*)(ws + WS_A), (bf16_t*)(ws + WS_B), bh >> 2, bh & 3, 15 - s, (const float*)(ws + WS_BT), lam, args.in[7], nullptr);
                att::attn_unit<0>(F.lds, (const bf16_t*)(ws + WS_A), (bf16_t*)(ws + WS_B), bh >> 2, bh & 3, s, (const float*)(ws + WS_BT), lam, args.in[7], nullptr); }
            } else { if constexpr (is_mega(11)) {
                if ((int)blockIdx.x < 128) att::cum_scan(F.lds, (const float*)(ws + WS_LF), args.in[10], (float*)(ws + WS_CUM), (int)blockIdx.x); }
            }
        } else if (q == 3) {
            if (layer == 0) { if constexpr (is_mega(3)) {
                const int bh = F.vcu >> 3, s = F.vcu & 7;
                ret::r1_unit(F.lds, (const bf16_t*)(ws + WS_A), (float*)(ws + WS_D), bh >> 2, bh & 3, s);
                ret::r1_unit(F.lds, (const bf16_t*)(ws + WS_A), (float*)(ws + WS_D), bh >> 2, bh & 3, s + 8);
                GRID_BAR();
                ret::r2_unit(F.lds, (const bf16_t*)(ws + WS_A), (const float*)(ws + WS_D), (bf16_t*)(ws + WS_B), args.in[8], bh >> 2, bh & 3, s + 8);
                ret::r2_unit(F.lds, (const bf16_t*)(ws + WS_A), (const float*)(ws + WS_D), (bf16_t*)(ws + WS_B), args.in[8], bh >> 2, bh & 3, s); }
            }
            if (layer == 1) { if constexpr (is_mega(12)) {
                const int bh = F.vcu >> 1, s = F.vcu & 1;
#pragma nounroll
                for (int i = 0; i < 4; ++i) { const int qb = i == 0 ? 7 - 2 * s : i == 1 ? 6 - 2 * s : i == 2 ? 2 * s + 1 : 2 * s;
                    att::attn_unit<1>(F.lds, (const bf16_t*)(ws + WS_A), (bf16_t*)(ws + WS_B), bh >> 4, bh & 15, qb, nullptr, 0.f, nullptr, (const float*)(ws + WS_CUM)); } }
            }
        } else if (q == 4) { if constexpr (is_mega(4)) {
            { int t_ = threadIdx.x; asm volatile("" : "+v"(t_)); const int ln = t_ & 63;
              const float* p = args.in[1] + (size_t)layer * T * 256; bf16_t* pb = (bf16_t*)(ws + WS_D); const int gw = F.vcu * NWAVES + F.wave, NGW = F.G * NWAVES;
              for (int m = gw; m < T; m += NGW) { const f32x4 v = *((const f32x4*)(p + (size_t)m * 256) + ln); v2u w; w.x = pk2(v[0], v[1]); w.y = pk2(v[2], v[3]); *((v2u*)(pb + (size_t)m * 256) + ln) = w; } }
            pg8::DenseOrder S; S.init(ws + WS_B, ws + (layer == 0 ? W_OUT0 : W_OUT1), T, DM, DM, F.G, (int)blockIdx.x);
            pg8::EpiF32 E{(float*)(ws + WS_A), DM};
            pg8::gemm_phase<pg8::EpiF32, pg8::DenseOrder, false, false>(F.lds + RING_OFF, DM, S, E); }
        } else if (q == 5) { if constexpr (is_mega(5)) {
            ph_ln1_route(F, layer == 0 ? args.in[0] : args.out, (const float*)(ws + WS_A), args.in[12] + layer * DM, args.in[13] + layer * DM, args.in[3], args.out, (bf16_t*)(ws + WS_B), cnt, tok_ep, tok_g, list, listg); }
        } else if (q == 6) { if constexpr (is_mega(6)) {
            moe_tables(F, cnt);
            MoeOrder S{(const LAS int*)(F.lds + MOE_TAB_OFF), (LAS unsigned short*)(F.lds + VOFF_OFF), (const char*)(ws + WS_B), (const char*)(ws + W_GU) + (size_t)layer * 32 * MiB, 2 * MiB, 512 * 1024, F.G, F.vcu, 0};
            S.build(list);
            pg8::EpiGateUp E{(bf16_t*)(ws + WS_ACT)};
            pg8::gemm_phase<pg8::EpiGateUp, MoeOrder, true, true>(F.lds + RING_OFF, DM, S, E);
            pg8::DenseOrder S2; S2.init(ws + WS_D, ws + W_PLEP + (size_t)layer * 512 * 1024, T, DM, 256, F.G, (int)blockIdx.x);
            pg8::EpiBf16 E2{(bf16_t*)(ws + WS_PP), DM};
            pg8::gemm_phase<pg8::EpiBf16, pg8::DenseOrder, false, false>(F.lds + RING_OFF, 256, S2, E2); }
        } else if (q == 7) { if constexpr (is_mega(7)) {
            moe_tables(F, cnt);
            MoeOrder S{(const LAS int*)(F.lds + MOE_TAB_OFF), (LAS unsigned short*)(F.lds + VOFF_OFF), (const char*)(ws + WS_ACT), (const char*)(ws + W_DN) + (size_t)layer * 16 * MiB, 1 * MiB, 256 * 1024, F.G, F.vcu, 1024};
            pg8::EpiDown E{(bf16_t*)(ws + WS_YS), listg};
            pg8::gemm_phase<pg8::EpiDown, MoeOrder, true, false>(F.lds + RING_OFF, 512, S, E); }
        } else if (q == 8) { if constexpr (is_mega(8)) {
            moe_tables(F, cnt);
            ph_ln2(F, args.out, (const bf16_t*)(ws + WS_YS), tok_ep, args.in[14] + layer * DM, args.in[15] + layer * DM, (bf16_t*)(ws + WS_B)); }
        } else if (q == 9) { if constexpr (is_mega(9)) {
            pg8::DenseOrder S; S.init(ws + WS_B, ws + W_PLEG + (size_t)layer * 2 * MiB, T, DM, DM, F.G, (int)blockIdx.x);
            pg8::EpiPle E{args.out, (const bf16_t*)(ws + WS_PP), (bf16_t*)(ws + WS_D)};
            pg8::gemm_phase<pg8::EpiPle, pg8::DenseOrder, false, false>(F.lds + RING_OFF, DM, S, E); }
        }
        if (ph + 1 < hi) GRID_BAR();
    }
#undef GRID_BAR
}

static void launch_mega(int lo, int hi, int li, int grid, void* const* d_in, void* d_out, void* d_ws, hipStream_t stream) {
    Args a{};
    for (int i = 0; i < 21; ++i) a.in[i] = (const float*)d_in[i];
    a.out = (float*)d_out; a.ws = (unsigned char*)d_ws; a.ph_lo = lo; a.ph_hi = hi; a.li = li; a.pad = 0;
    void* kargs[] = {&a};
    const hipError_t e = hipLaunchCooperativeKernel((const void*)mega_fwd, dim3(grid), dim3(NWAVES * 64), kargs, LDS_BYTES, stream);
    if (e != hipSuccess) fprintf(stderr, "kernel_launch: cooperative launch of phases [%d,%d) failed: %s (grid %d)\n", lo, hi, hipGetErrorString(e), grid);
}

static void naive_phase(int ph, void* const* d_in, void* d_out, void* d_ws, hipStream_t st) {
    using namespace nv;
    unsigned char* ws = (unsigned char*)d_ws;
    const float* x = (const float*)d_in[0]; const float* p = (const float*)d_in[1]; const float* router_w = (const float*)d_in[3];
    const float* even_w_in = (const float*)d_in[4]; const float* even_w_out = (const float*)d_in[5];
    const float* diff_g = (const float*)d_in[7]; const float* ret_g = (const float*)d_in[8];
    const float* odd_w_in = (const float*)d_in[9]; const float* odd_bf = (const float*)d_in[10]; const float* odd_w_out = (const float*)d_in[11];
    const float* ln_mix_g = (const float*)d_in[12]; const float* ln_mix_b = (const float*)d_in[13]; const float* ln_ffn_g = (const float*)d_in[14]; const float* ln_ffn_b = (const float*)d_in[15];
    const float* moe_g = (const float*)d_in[16]; const float* moe_u = (const float*)d_in[17]; const float* moe_d = (const float*)d_in[18];
    const float* ple_proj = (const float*)d_in[19]; const float* ple_gate = (const float*)d_in[20];
    float* out = (float*)d_out;
    bf16_t* UB = (bf16_t*)(ws + WS_A); float* MIX = (float*)(ws + WS_A); float* FFN = (float*)(ws + WS_A); float* G = (float*)(ws + WS_A);
    bf16_t* Y = (bf16_t*)(ws + WS_B); bf16_t* HB = (bf16_t*)(ws + WS_B); bf16_t* XB = (bf16_t*)(ws + WS_D); bf16_t* PP = (bf16_t*)(ws + WS_PP);
    const float2* rope = (const float2*)(ws + WS_ROPE); const float* bt = (const float*)(ws + WS_BT); const float* lamp = (const float*)(ws + WS_LAM);
    float* cum = (float*)(ws + WS_CUM); float* LF = (float*)(ws + WS_LF);
    const int layer = ph >= 10 ? 1 : 0; const int q = ph >= 10 ? ph - 9 : ph;
    const size_t TD = (size_t)T * DM;
    switch (q) {
    case 1:
        if (layer == 0) { gemm<float, bf16_t>(st, x, DM, even_w_in, EVEN_IN, UB, UBW, T, EVEN_IN, DM, SCQ, 512);
                          hipLaunchKernelGGL(rope_apply, dim3(T * 4 * 32 / 256), dim3(256), 0, st, UB, rope); }
        else { gemm<bf16_t, bf16_t>(st, XB, DM, odd_w_in, ODD_IN, UB, UBW, T, 3072, DM, SCQ, 1024);
               gemm<bf16_t, float>(st, XB, DM, odd_w_in + 3072, ODD_IN, LF, 16, T, 16, DM);
             }
        break;
    case 2:
        if (layer == 0) hipLaunchKernelGGL(diff_attn_nv, dim3(BATCH * 4 * SEQ), dim3(64), 0, st, UB, Y, bt, lamp, diff_g);
        else hipLaunchKernelGGL(fox_cum, dim3(1), dim3(128), 0, st, LF, odd_bf, cum);
        break;
    case 3:
        if (layer == 0) hipLaunchKernelGGL(retention_nv, dim3(BATCH * 4 * SEQ), dim3(64), 0, st, UB, Y, ret_g);
        else hipLaunchKernelGGL(fox_attn_nv, dim3(BATCH * 16 * SEQ), dim3(64), 0, st, UB, cum, Y);
        break;
    case 4: gemm<bf16_t, float>(st, Y, DM, layer == 0 ? even_w_out : odd_w_out, DM, MIX, DM, T, DM, DM); break;
    case 5: hipLaunchKernelGGL((ln_nv<float>), dim3(T / 4), dim3(256), 0, st, layer == 0 ? x : out, MIX, ln_mix_g + layer * DM, ln_mix_b + layer * DM, out, HB); break;
    case 6:
#ifdef DIAG_SLOTS
        if (layer == 0) {
        hipLaunchKernelGGL(moe_slots_nv, dim3(2 * T), dim3(256), 0, st, HB, (const unsigned*)(ws + WS_CTL) + CW_CNT + layer * 16 * 64, (const int*)(ws + WS_LIST), (const float*)(ws + WS_LISTG),
                           moe_g + (size_t)layer * 16 * DM * 512, moe_u + (size_t)layer * 16 * DM * 512, moe_d + (size_t)layer * 16 * 512 * DM, (bf16_t*)(ws + WS_YS));
        gemm<float, bf16_t>(st, p + (size_t)layer * T * 256, 256, ple_proj + (size_t)layer * 256 * DM, DM, PP, DM, T, DM, 256);
        break; }
#endif
        hipLaunchKernelGGL(moe_nv, dim3(T), dim3(256), 0, st, out, router_w, moe_g + (size_t)layer * 16 * DM * 512, moe_u + (size_t)layer * 16 * DM * 512, moe_d + (size_t)layer * 16 * 512 * DM, FFN);
        gemm<float, bf16_t>(st, p + (size_t)layer * T * 256, 256, ple_proj + (size_t)layer * 256 * DM, DM, PP, DM, T, DM, 256);
        break;
    case 7: break;
    case 8: hipLaunchKernelGGL((ln_nv<float>), dim3(T / 4), dim3(256), 0, st, out, FFN, ln_ffn_g + layer * DM, ln_ffn_b + layer * DM, out, HB); break;
    case 9:
        gemm<bf16_t, float>(st, HB, DM, ple_gate + (size_t)layer * DM * DM, DM, G, DM, T, DM, DM);
        hipLaunchKernelGGL(ple_final, dim3((int)(TD / 256)), dim3(256), 0, st, out, G, PP, out, XB, (int)TD);
        break;
    }
}

extern "C" void kernel_launch(void* const* d_in, const int* in_sizes, int n_in, void* d_out, int out_size, void* d_ws, size_t ws_size, hipStream_t stream) {
    static int grid = 0;
    if (grid == 0) {
        if (n_in != 21 || in_sizes[0] != T * DM || out_size != T * DM || ws_size < WS_END) {
            fprintf(stderr, "kernel_launch: unexpected problem (n_in %d, in0 %d, out %d, ws %zu < %zu); nothing launched\n", n_in, n_in > 0 ? in_sizes[0] : -1, out_size, ws_size, (size_t)WS_END); grid = -1; return; }
        int dev = 0, cus = 0, per_cu = 0;
        if (hipGetDevice(&dev) != hipSuccess || hipDeviceGetAttribute(&cus, hipDeviceAttributeMultiprocessorCount, dev) != hipSuccess) { grid = -1; return; }
        if (hipFuncSetAttribute((const void*)mega_fwd, hipFuncAttributeMaxDynamicSharedMemorySize, LDS_BYTES) != hipSuccess) { fprintf(stderr, "kernel_launch: hipFuncSetAttribute failed\n"); grid = -1; return; }
        if (hipOccupancyMaxActiveBlocksPerMultiprocessor(&per_cu, (const void*)mega_fwd, NWAVES * 64, LDS_BYTES) != hipSuccess || per_cu < 1) {
            fprintf(stderr, "kernel_launch: occupancy query says %d workgroups per CU; nothing launched\n", per_cu); grid = -1; return; }
        (void)hipGetLastError();
        grid = cus;
    }
    if (grid < 0) return;
    if (grid != 256) { fprintf(stderr, "kernel_launch: this kernel is laid out for 256 CUs (got %d); nothing launched\n", grid); return; }
    (void)hipMemsetAsync((char*)d_ws + WS_CTL, 0, CTL_ZERO_BYTES, stream);
    int li = 0, lo = -1;
    for (int ph = 0; ph <= NPH; ++ph) {
        const bool mg = ph < NPH && is_mega(ph);
        if (mg) { if (lo < 0) lo = ph; continue; }
        if (lo >= 0) { launch_mega(lo, ph, li++, grid, d_in, d_out, d_ws, stream); lo = -1; }
        if (ph < NPH) naive_phase(ph, d_in, d_out, d_ws, stream);
    }
}
```
